# Optimizing an MI355X kernel written in HIP

```python
import jax, jax.numpy as jnp
from jax import lax
import numpy as np

D_MODEL = 2048
BATCH = 4
SEQ = 4096
DEPTH = 1

GRID_W = 64
CTX_LEN = 256
D_CONV = D_MODEL // 2
D_RWKV = D_MODEL // 2
D_MIX = D_CONV + D_RWKV
HEAD_SIZE = 64
N_HEADS_RWKV = D_RWKV // HEAD_SIZE
CONV_WIDTH = 3
W_LORA = 64
A_LORA = 64
G_LORA = 160
P_STATE = 2 * D_RWKV + 2 * W_LORA + 2 * A_LORA
P_RWKV = P_STATE + D_RWKV + G_LORA
P_IN = 3 * D_CONV + P_RWKV
N_EXPERTS = 32
TOP_K = 4
D_EXPERT = D_MODEL
SWIGLU_LIMIT = 7.0
SWIGLU_ALPHA = 1.702
EXPERT_BLOCK = 256
RMS_EPS = 1e-6
LNX_EPS = 64e-5
KK_EPS = 1e-24

kernel_name = 'hybrid_conv_rwkv7_moe_diffusion_block'


def rms_norm(x, g):
    xf = x.astype(jnp.float32)
    y = xf * lax.rsqrt(jnp.mean(xf * xf, axis=-1, keepdims=True) + RMS_EPS)
    return (y * g).astype(x.dtype)


def modulate(x, shift, scale):
    return x * (1.0 + scale) + shift


def split_heads(z):
    return z.reshape(z.shape[:-1] + (N_HEADS_RWKV, HEAD_SIZE))


def token_shift(p, mu):
    prev = jnp.pad(p[:, :-1], ((0, 0), (1, 0), (0, 0)))
    nxt = jnp.pad(p[:, 1:], ((0, 0), (0, 1), (0, 0)))
    return p + mu[0] * (prev - p) + mu[1] * (nxt - p)


def conv3(u_pad, w):
    return u_pad[..., :-2, :] * w[0] + u_pad[..., 1:-1, :] * w[1] + u_pad[..., 2:, :] * w[2]


def short_conv_latent(u, w):
    bsz, n_tok, ch = u.shape
    rows = n_tok // GRID_W
    grid = jnp.pad(u.reshape(bsz, rows, GRID_W, ch), ((0, 0), (0, 0), (1, 1), (0, 0)))
    return conv3(grid, w).reshape(bsz, n_tok, ch)


def short_conv_context(u, w):
    return conv3(jnp.pad(u, ((0, 0), (1, 1), (0, 0))), w)


def conv_group(p, w, conv_fn):
    gate_b = p[..., :D_CONV]
    gate_c = p[..., D_CONV:2 * D_CONV]
    u = p[..., 2 * D_CONV:3 * D_CONV]
    return gate_b * conv_fn(gate_c * u, w)


def rwkv_state_inputs(q, w0, w_up, a0, a_up, k_k, k_a):
    bsz, n_tok, _ = q.shape
    k = q[..., :D_RWKV]
    v = q[..., D_RWKV:2 * D_RWKV]
    off = 2 * D_RWKV
    w_low = q[..., off:off + 2 * W_LORA].reshape(bsz, n_tok, 2, W_LORA)
    off += 2 * W_LORA
    a_low = q[..., off:off + 2 * A_LORA].reshape(bsz, n_tok, 2, A_LORA)
    w_log = w0 + jnp.einsum('btdl,dlc->btdc', jnp.tanh(w_low), w_up)
    w_log = -jax.nn.softplus(-w_log.astype(jnp.float32)) - 0.5
    decay = jnp.exp(-jnp.exp(w_log))
    a = jax.nn.sigmoid(a0 + jnp.einsum('btdl,dlc->btdc', a_low, a_up))
    kk = split_heads(k * k_k).astype(jnp.float32)
    kk = kk * lax.rsqrt(jnp.maximum(jnp.sum(kk * kk, axis=-1, keepdims=True), KK_EPS))
    k_dir = k[:, :, None, :] * (1.0 + (a - 1.0) * k_a)
    return (split_heads(decay), split_heads(k_dir), split_heads(v), kk, split_heads(a))


def wkv_scan(decay, k, a_vec, b_vec, v, r, s0, reverse):
    seq = [jnp.moveaxis(z, 1, 0) for z in (decay, k, a_vec, b_vec, v)]
    emit = r is not None
    if emit:
        seq.append(jnp.moveaxis(r, 1, 0))

    def step(s, inp):
        w_t, k_t, a_t, b_t, v_t = inp[:5]
        sa = jnp.einsum('bhvk,bhk->bhv', s, a_t)
        s = s * w_t[:, :, None, :] + sa[..., None] * b_t[:, :, None, :] + v_t[..., None] * k_t[:, :, None, :]
        y = jnp.einsum('bhvk,bhk->bhv', s, inp[5]) if emit else None
        return s, y

    s, ys = lax.scan(step, s0, tuple(seq), reverse=reverse)
    return s, (jnp.moveaxis(ys, 0, 1) if emit else None)


def bidirectional_wkv(inputs, r, s_init):
    decay, k_dir, v, kk, a = inputs
    states, outs = [], []
    for d, reverse in enumerate((False, True)):
        s, y = wkv_scan(decay[:, :, d], k_dir[:, :, d], -kk, kk * a[:, :, d], v, r, s_init[d], reverse)
        states.append(s)
        outs.append(y)
    return states, outs


def rwkv_readout(outs, r, inputs, r_k, lnx_w, lnx_b, g):
    _, k_dir, v, _, _ = inputs
    o = None
    for d in range(2):
        y = outs[d]
        mu = jnp.mean(y, axis=-1, keepdims=True)
        var = jnp.mean(jnp.square(y - mu), axis=-1, keepdims=True)
        o_d = (y - mu) * lax.rsqrt(var + LNX_EPS) * split_heads(lnx_w) + split_heads(lnx_b)
        o_d = o_d + jnp.sum(r * k_dir[:, :, d] * r_k, axis=-1, keepdims=True) * v
        o = o_d if o is None else o + o_d
    return o.reshape(o.shape[:2] + (D_RWKV,)).astype(g.dtype) * g


def mixer_output(p, q, r, inputs, outs, conv_fn, conv_w, r_k, lnx_w, lnx_b, g_up, w_out):
    y_conv = conv_group(p, conv_w, conv_fn)
    g = jax.nn.sigmoid(q[..., P_STATE + D_RWKV:]) @ g_up
    y_rwkv = rwkv_readout(outs, r, inputs, r_k, lnx_w, lnx_b, g)
    return jnp.concatenate([y_conv, y_rwkv], axis=-1) @ w_out


def clamped_swiglu(gu):
    x_glu = jnp.minimum(gu[..., ::2], SWIGLU_LIMIT)
    x_lin = jnp.clip(gu[..., 1::2], -SWIGLU_LIMIT, SWIGLU_LIMIT)
    return x_glu * jax.nn.sigmoid(SWIGLU_ALPHA * x_glu) * (x_lin + 1.0)


def moe_ffn(h, w_router, b_router, w_gu, b_gu, w_dn, b_dn):
    bsz, n_tok_seq, d = h.shape
    tokens = h.reshape(-1, d)
    n_tok = tokens.shape[0]
    logits = (tokens @ w_router + b_router).astype(jnp.float32)
    top_val, top_idx = lax.top_k(logits, TOP_K)
    gate = jax.nn.softmax(top_val, axis=-1)
    n_assign = n_tok * TOP_K
    e_flat = top_idx.reshape(-1)
    tok_flat = jnp.arange(n_assign, dtype=jnp.int32) // TOP_K
    order = jnp.argsort(e_flat)
    e_sorted = e_flat[order]
    counts = jnp.bincount(e_flat, length=N_EXPERTS)
    padded = ((counts + EXPERT_BLOCK - 1) // EXPERT_BLOCK) * EXPERT_BLOCK
    start = jnp.cumsum(counts) - counts
    pstart = jnp.cumsum(padded) - padded
    dest = pstart[e_sorted] + (jnp.arange(n_assign, dtype=jnp.int32) - start[e_sorted])
    n_blocks = -(-n_assign // EXPERT_BLOCK) + N_EXPERTS
    slots = n_blocks * EXPERT_BLOCK
    slot_tok = jnp.zeros((slots,), jnp.int32).at[dest].set(tok_flat[order])
    slot_w = jnp.zeros((slots,), jnp.float32).at[dest].set(gate.reshape(-1)[order])
    pend = jnp.cumsum(padded)
    block_first = jnp.arange(n_blocks, dtype=jnp.int32) * EXPERT_BLOCK
    block_e = jnp.minimum(jnp.sum(block_first[:, None] >= pend[None, :], axis=-1), N_EXPERTS - 1)

    def block(acc, inp):
        tok, wgt, e = inp
        xb = tokens[tok]
        act = clamped_swiglu(xb @ w_gu[e] + b_gu[e])
        y = act @ w_dn[e] + b_dn[e]
        return acc.at[tok].add(y * wgt[:, None]), None

    acc, _ = lax.scan(block, jnp.zeros((n_tok, d), jnp.float32),
                      (slot_tok.reshape(n_blocks, EXPERT_BLOCK), slot_w.reshape(n_blocks, EXPERT_BLOCK), block_e))
    return acc.reshape(bsz, n_tok_seq, d).astype(h.dtype)


def setup_inputs(seed: int = 0) -> dict:
    key = jax.random.key(seed)
    ks = jax.random.split(key, 27)
    f32 = jnp.float32
    L = DEPTH

    def nrm(k, shape, s):
        return jax.random.normal(k, shape, f32) * s

    return {
        'x': nrm(ks[0], (BATCH, SEQ, D_MODEL), 1.0),
        'c': nrm(ks[1], (BATCH, D_MODEL), 1.0),
        'ctx': nrm(ks[2], (BATCH, CTX_LEN, D_MODEL), 1.0),
        'c_ctx': nrm(ks[3], (D_MODEL,), 1.0),
        'w_mod': nrm(ks[4], (L, D_MODEL, 6 * D_MODEL), D_MODEL ** -0.5),
        'b_mod': nrm(ks[5], (L, 6 * D_MODEL), 0.02),
        'norm_g': 1.0 + nrm(ks[6], (L, 4, D_MODEL), 0.1),
        'w_in': nrm(ks[7], (L, D_MODEL, P_IN), D_MODEL ** -0.5),
        'conv_w': nrm(ks[8], (L, CONV_WIDTH, D_CONV), CONV_WIDTH ** -0.5),
        'mu_shift': jax.random.uniform(ks[9], (L, 2, P_RWKV), f32, 0.0, 0.5),
        'w0': jax.random.uniform(ks[10], (L, 2, D_RWKV), f32, -6.5, -1.5),
        'w_up': nrm(ks[11], (L, 2, W_LORA, D_RWKV), 0.5 * W_LORA ** -0.5),
        'a0': nrm(ks[12], (L, 2, D_RWKV), 0.5),
        'a_up': nrm(ks[13], (L, 2, A_LORA, D_RWKV), 0.5 * A_LORA ** -0.5),
        'k_k': 0.85 + nrm(ks[14], (L, D_RWKV), 0.1),
        'k_a': 1.0 + nrm(ks[15], (L, D_RWKV), 0.1),
        'r_k': nrm(ks[16], (L, N_HEADS_RWKV, HEAD_SIZE), 0.1),
        'lnx_w': 1.0 + nrm(ks[17], (L, D_RWKV), 0.1),
        'lnx_b': nrm(ks[18], (L, D_RWKV), 0.02),
        'g_up': nrm(ks[19], (L, G_LORA, D_RWKV), G_LORA ** -0.5),
        'w_out': nrm(ks[20], (L, D_MIX, D_MODEL), D_MIX ** -0.5),
        'w_router': nrm(ks[21], (L, D_MODEL, N_EXPERTS), D_MODEL ** -0.5),
        'b_router': nrm(ks[22], (L, N_EXPERTS), 0.01),
        'w_gu': nrm(ks[23], (L, N_EXPERTS, D_MODEL, 2 * D_EXPERT), D_MODEL ** -0.5),
        'b_gu': nrm(ks[24], (L, N_EXPERTS, 2 * D_EXPERT), 0.02),
        'w_dn': nrm(ks[25], (L, N_EXPERTS, D_EXPERT, D_MODEL), D_EXPERT ** -0.5),
        'b_dn': nrm(ks[26], (L, N_EXPERTS, D_MODEL), 0.02),
    }


def reference(x, c, ctx, c_ctx, w_mod, b_mod, norm_g, w_in, conv_w, mu_shift, w0, w_up, a0, a_up,
              k_k, k_a, r_k, lnx_w, lnx_b, g_up, w_out, w_router, b_router, w_gu, b_gu, w_dn, b_dn):
    bsz = x.shape[0]
    for layer in range(DEPTH):
        last = layer == DEPTH - 1
        g_pre_mix, g_post_mix, g_pre_ffn, g_post_ffn = norm_g[layer]
        mod_lat = (jax.nn.silu(c) @ w_mod[layer] + b_mod[layer])[:, None, :]
        mod_ctx = (jax.nn.silu(c_ctx) @ w_mod[layer] + b_mod[layer])[None, None, :]
        shift1, scale1, gate1, shift2, scale2, gate2 = jnp.split(mod_lat, 6, axis=-1)
        cshift1, cscale1, cgate1, cshift2, cscale2, cgate2 = jnp.split(mod_ctx, 6, axis=-1)
        rw = (w0[layer], w_up[layer], a0[layer], a_up[layer], k_k[layer], k_a[layer])
        head_p = (r_k[layer], lnx_w[layer], lnx_b[layer], g_up[layer], w_out[layer])
        experts = (w_router[layer], b_router[layer], w_gu[layer], b_gu[layer], w_dn[layer], b_dn[layer])

        h_ctx = modulate(rms_norm(ctx, g_pre_mix), cshift1, cscale1)
        zero_state = jnp.zeros((bsz, N_HEADS_RWKV, HEAD_SIZE, HEAD_SIZE), jnp.float32)
        if last:
            q_ctx = token_shift(h_ctx @ w_in[layer][:, 3 * D_CONV:3 * D_CONV + P_STATE],
                                mu_shift[layer][:, :P_STATE])
            r_ctx = None
        else:
            p_ctx = h_ctx @ w_in[layer]
            q_ctx = token_shift(p_ctx[..., 3 * D_CONV:], mu_shift[layer])
            r_ctx = split_heads(q_ctx[..., P_STATE:P_STATE + D_RWKV])
        in_ctx = rwkv_state_inputs(q_ctx[..., :P_STATE], *rw)
        ctx_states, outs_ctx = bidirectional_wkv(in_ctx, r_ctx, (zero_state, zero_state))

        h = modulate(rms_norm(x, g_pre_mix), shift1, scale1)
        p = h @ w_in[layer]
        q = token_shift(p[..., 3 * D_CONV:], mu_shift[layer])
        in_lat = rwkv_state_inputs(q[..., :P_STATE], *rw)
        r = split_heads(q[..., P_STATE:P_STATE + D_RWKV])
        _, outs = bidirectional_wkv(in_lat, r, ctx_states)
        mix = mixer_output(p, q, r, in_lat, outs, short_conv_latent, conv_w[layer], *head_p)
        x = x + gate1 * rms_norm(mix, g_post_mix)
        ffn = moe_ffn(modulate(rms_norm(x, g_pre_ffn), shift2, scale2), *experts)
        x = x + gate2 * rms_norm(ffn, g_post_ffn)

        if not last:
            mix_c = mixer_output(p_ctx, q_ctx, r_ctx, in_ctx, outs_ctx, short_conv_context, conv_w[layer], *head_p)
            ctx = ctx + cgate1 * rms_norm(mix_c, g_post_mix)
            ffn_c = moe_ffn(modulate(rms_norm(ctx, g_pre_ffn), cshift2, cscale2), *experts)
            ctx = ctx + cgate2 * rms_norm(ffn_c, g_post_ffn)
    return x
```

```cpp
#include <hip/hip_runtime.h>
#include <cstdio>
#include <cstdint>

#define GAS __attribute__((address_space(1)))
#define LAS __attribute__((address_space(3)))
typedef unsigned short bf16_t;
typedef short bf16x8 __attribute__((ext_vector_type(8)));
typedef float f32x4 __attribute__((ext_vector_type(4)));
typedef float f32x2 __attribute__((ext_vector_type(2)));
typedef unsigned u32x4 __attribute__((ext_vector_type(4)));
typedef unsigned u32x2 __attribute__((ext_vector_type(2)));
typedef int i32x4 __attribute__((ext_vector_type(4)));
typedef int i32x8 __attribute__((ext_vector_type(8)));

namespace pg8 {
constexpr int BM = 256, BK = 64, HALF = 128, HTB = HALF * BK * 2, STAGE_BYTES = 8 * HTB, NXCD = 8, WGM = 8;
__host__ __device__ __forceinline__ int lds_byte(int r, int c) { const int st = (r >> 4) * 2 + (c >> 5), rr = r & 15, cc = c & 31, ob = rr * 64 + cc * 2; return st * 1024 + (ob ^ (((ob >> 9) & 1) << 5)); }
__host__ __device__ __forceinline__ void stage_rc(int b, int& R, int& C) { const int st = b / 1024, sb = b % 1024, swz = sb ^ (((sb >> 9) & 1) << 5); R = (st >> 1) * 16 + swz / 64; C = (st & 1) * 32 + (swz % 64) / 2; }
__host__ __device__ __forceinline__ int perm32(int rho) { const int n = rho >> 4, i = rho & 15; return 8 * (i >> 2) + 4 * n + (i & 3); }

struct Unit { int pm, pn; };
struct Gemm { const void* A; const void* Bt; int rowbytes; };

__device__ __forceinline__ unsigned cvt_pk_bf16(float lo, float hi) { unsigned r; asm volatile("v_cvt_pk_bf16_f32 %0, %1, %2" : "=v"(r) : "v"(lo), "v"(hi)); return r; }

struct ListOrder {
    const LAS int* list; int n;
    __device__ __forceinline__ bool next(int i, Unit& u) const { if (i >= n) return false; u.pm = list[2 * i]; u.pn = list[2 * i + 1]; return true; }
    __device__ __forceinline__ void a_ready(const Unit&) const {}
    __device__ __forceinline__ void done(const Unit&) const {}
};

struct EpiF32 {
    static constexpr bool PERM = false;
    float* C; int ldc;
    __device__ __forceinline__ void operator()(const f32x4 (&acc)[2][2][4][2], const Unit& u, int wr, int wc, int fr, int fq) const {
        const int row0 = u.pm * BM + wr * 64 + fr, col0 = u.pn * BM + wc * 32 + 4 * fq;
#pragma unroll
        for (int ai = 0; ai < 2; ++ai)
#pragma unroll
            for (int m = 0; m < 4; ++m) { float* rowp = C + (size_t)(row0 + ai * HALF + m * 16) * ldc + col0;
#pragma unroll
                for (int bj = 0; bj < 2; ++bj)
#pragma unroll
                    for (int n = 0; n < 2; ++n) *(f32x4*)(rowp + bj * HALF + n * 16) = acc[ai][bj][m][n]; }
    }
};
struct EpiBf16 {
    static constexpr bool PERM = true;
    bf16_t* O; int ldc; const float* bias; int npn; int bias_ld; float scale;
    __device__ __forceinline__ void operator()(const f32x4 (&acc)[2][2][4][2], const Unit& u, int wr, int wc, int fr, int fq) const {
        const int e = u.pn / npn, pnl = u.pn - e * npn;
        const int row0 = u.pm * BM + wr * 64 + fr; const int col0 = pnl * BM + wc * 32 + 8 * fq;
        f32x4 bv[2][2];
#pragma unroll
        for (int bj = 0; bj < 2; ++bj)
#pragma unroll
            for (int n = 0; n < 2; ++n) bv[bj][n] = bias ? *(const f32x4*)(bias + (size_t)e * bias_ld + col0 + bj * HALF + 4 * n) : (f32x4){0.f, 0.f, 0.f, 0.f};
#pragma unroll
        for (int ai = 0; ai < 2; ++ai)
#pragma unroll
            for (int m = 0; m < 4; ++m) { bf16_t* rowp = O + (size_t)(row0 + ai * HALF + m * 16) * ldc + col0;
#pragma unroll
                for (int bj = 0; bj < 2; ++bj) { const f32x4 v0 = acc[ai][bj][m][0] * scale + bv[bj][0], v1 = acc[ai][bj][m][1] * scale + bv[bj][1];
                    u32x4 w; w.x = cvt_pk_bf16(v0[0], v0[1]); w.y = cvt_pk_bf16(v0[2], v0[3]); w.z = cvt_pk_bf16(v1[0], v1[1]); w.w = cvt_pk_bf16(v1[2], v1[3]);
                    *(u32x4*)(rowp + bj * HALF) = w; } }
    }
};
struct EpiNone { static constexpr bool PERM = true; float* sink;
    __device__ __forceinline__ void operator()(const f32x4 (&acc)[2][2][4][2], const Unit& u, int wr, int wc, int fr, int fq) const {
        float t = 0.f;
#pragma unroll
        for (int ai = 0; ai < 2; ++ai)
#pragma unroll
            for (int bj = 0; bj < 2; ++bj)
#pragma unroll
                for (int m = 0; m < 4; ++m)
#pragma unroll
                    for (int n = 0; n < 2; ++n) t += acc[ai][bj][m][n][0];
        if (t == 123456.789f) *sink = t; } };
__device__ __forceinline__ float swiglu1(float g, float l) {
    g = fminf(g, 7.0f); l = fminf(fmaxf(l, -7.0f), 7.0f);
    const float s = __builtin_amdgcn_rcpf(1.0f + __expf(-1.702f * g));
    return g * s * (l + 1.0f);
}
__device__ __forceinline__ unsigned pk4_fp8(float a, float b, float c, float d) { int w = 0; w = __builtin_amdgcn_cvt_pk_fp8_f32(a, b, w, false); w = __builtin_amdgcn_cvt_pk_fp8_f32(c, d, w, true); return (unsigned)w; }
struct EpiSwiglu {
    static constexpr bool PERM = true;
    unsigned char* O; int ldc; const float* bias; int npn; int bias_ld; float scale;
    __device__ __forceinline__ void operator()(const f32x4 (&acc)[2][2][4][2], const Unit& u, int wr, int wc, int fr, int fq) const {
        const int e = u.pn / npn, pnl = u.pn - e * npn;
        const int row0 = u.pm * BM + wr * 64 + fr; const int col0 = pnl * BM + wc * 32 + 8 * fq;
        f32x4 bv[2][2];
#pragma unroll
        for (int bj = 0; bj < 2; ++bj)
#pragma unroll
            for (int n = 0; n < 2; ++n) bv[bj][n] = *(const f32x4*)(bias + (size_t)e * bias_ld + col0 + bj * HALF + 4 * n);
#pragma unroll
        for (int ai = 0; ai < 2; ++ai)
#pragma unroll
            for (int m = 0; m < 4; ++m) { unsigned char* rowp = O + (size_t)(row0 + ai * HALF + m * 16) * ldc + (col0 >> 1);
#pragma unroll
                for (int bj = 0; bj < 2; ++bj) { const f32x4 v0 = acc[ai][bj][m][0] * scale + bv[bj][0], v1 = acc[ai][bj][m][1] * scale + bv[bj][1];
                    *(unsigned*)(rowp + bj * (HALF / 2)) = pk4_fp8(swiglu1(v0[0], v0[1]), swiglu1(v0[2], v0[3]), swiglu1(v1[0], v1[1]), swiglu1(v1[2], v1[3])); } }
    }
};

constexpr int STG_PITCH = 528, STG8_PITCH = 144;
struct EpiBf16S {
    static constexpr bool PERM = true;
    bf16_t* O; int ldc; const float* bias; int npn; int bias_ld; float scale; LAS unsigned char* stg;
    __device__ __forceinline__ void operator()(const f32x4 (&acc)[2][2][4][2], const Unit& u, int wr, int wc, int fr, int fq) const {
        const int e = u.pn / npn, pnl = u.pn - e * npn; const int tid = threadIdx.x;
        const int col0 = pnl * BM + wc * 32 + 8 * fq;
        f32x4 bv[2][2];
#pragma unroll
        for (int bj = 0; bj < 2; ++bj)
#pragma unroll
            for (int n = 0; n < 2; ++n) bv[bj][n] = bias ? *(const f32x4*)(bias + (size_t)e * bias_ld + col0 + bj * HALF + 4 * n) : (f32x4){0.f, 0.f, 0.f, 0.f};
        LAS unsigned char* wp = stg + (16 * wr + fr) * STG_PITCH + 64 * wc + 16 * fq;
        const int rr = tid >> 4, cc = tid & 15; const LAS unsigned char* rp = stg + rr * STG_PITCH + cc * 16;
        bf16_t* gp = O + (size_t)(u.pm * BM + 64 * (rr >> 4) + (rr & 15)) * ldc + pnl * BM + cc * 8;
#pragma unroll
        for (int ai = 0; ai < 2; ++ai)
#pragma unroll
            for (int m = 0; m < 4; ++m) {
#pragma unroll
                for (int bj = 0; bj < 2; ++bj) { const f32x4 v0 = acc[ai][bj][m][0] * scale + bv[bj][0], v1 = acc[ai][bj][m][1] * scale + bv[bj][1];
                    u32x4 w; w.x = cvt_pk_bf16(v0[0], v0[1]); w.y = cvt_pk_bf16(v0[2], v0[3]); w.z = cvt_pk_bf16(v1[0], v1[1]); w.w = cvt_pk_bf16(v1[2], v1[3]);
                    *(LAS u32x4*)(wp + 256 * bj) = w; }
                asm volatile("s_waitcnt lgkmcnt(0)" ::: "memory"); __builtin_amdgcn_s_barrier(); asm volatile("" ::: "memory");
                bf16_t* g2 = gp + (size_t)(ai * HALF + m * 16) * ldc;
                *(u32x4*)(g2) = *(const LAS u32x4*)(rp); *(u32x4*)(g2 + HALF) = *(const LAS u32x4*)(rp + 256);
                asm volatile("s_waitcnt lgkmcnt(0)" ::: "memory"); __builtin_amdgcn_s_barrier(); asm volatile("" ::: "memory");
            }
    }
};
struct EpiSwigluS {
    static constexpr bool PERM = true;
    unsigned char* O; int ldc; const float* bias; int npn; int bias_ld; float scale; LAS unsigned char* stg;
    __device__ __forceinline__ void operator()(const f32x4 (&acc)[2][2][4][2], const Unit& u, int wr, int wc, int fr, int fq) const {
        const int e = u.pn / npn, pnl = u.pn - e * npn; const int tid = threadIdx.x;
        const int col0 = pnl * BM + wc * 32 + 8 * fq;
        f32x4 bv[2][2];
#pragma unroll
        for (int bj = 0; bj < 2; ++bj)
#pragma unroll
            for (int n = 0; n < 2; ++n) bv[bj][n] = *(const f32x4*)(bias + (size_t)e * bias_ld + col0 + bj * HALF + 4 * n);
        LAS unsigned char* wp = stg + (16 * wr + fr) * STG8_PITCH + 16 * wc + 4 * fq;
        const int rr = (tid >> 3) & 31, cc = tid & 7; const LAS unsigned char* rp = stg + rr * STG8_PITCH + cc * 16;
        unsigned char* gp = O + (size_t)(u.pm * BM + 64 * (rr >> 4) + (rr & 15)) * ldc + pnl * (BM / 2) + cc * 16;
#pragma unroll
        for (int ai = 0; ai < 2; ++ai)
#pragma unroll
            for (int m = 0; m < 4; ++m) {
#pragma unroll
                for (int bj = 0; bj < 2; ++bj) { const f32x4 v0 = acc[ai][bj][m][0] * scale + bv[bj][0], v1 = acc[ai][bj][m][1] * scale + bv[bj][1];
                    *(LAS unsigned*)(wp + 64 * bj) = pk4_fp8(swiglu1(v0[0], v0[1]), swiglu1(v0[2], v0[3]), swiglu1(v1[0], v1[1]), swiglu1(v1[2], v1[3])); }
                asm volatile("s_waitcnt lgkmcnt(0)" ::: "memory"); __builtin_amdgcn_s_barrier(); asm volatile("" ::: "memory");
                if (tid < 256) *(u32x4*)(gp + (size_t)(ai * HALF + m * 16) * ldc) = *(const LAS u32x4*)(rp);
                asm volatile("s_waitcnt lgkmcnt(0)" ::: "memory"); __builtin_amdgcn_s_barrier(); asm volatile("" ::: "memory");
            }
    }
};

struct GatherInfo { const int* elist; const LAS int* tab; const LAS int* rp; int npn; int nrep; int rcap; };
template <class Epi, class Sched, bool ALIGN_EPI, bool FP8, bool GATHER = false>
__device__ __forceinline__ void gemm_phase(LAS unsigned char* lds, const Gemm g, const Sched& S, const Epi& E, const GatherInfo GI = GatherInfo{nullptr, nullptr, nullptr, 1, 1, 0}) {
    const int tid = threadIdx.x, wid = __builtin_amdgcn_readfirstlane(tid >> 6), lane = tid & 63, wr = wid >> 2, wc = wid & 3, fr = lane & 15, fq = lane >> 4;
    const int RB = g.rowbytes, nt = RB / 128;
    unsigned voffA[2], voffB[2]; int rowA[2], colA2[2];
#pragma unroll
    for (int i = 0; i < 2; ++i) { int R, C; stage_rc(tid * 16 + i * 8192, R, C); const int Rb = Epi::PERM ? ((R & ~31) + perm32(R & 31)) : R;
        voffA[i] = (unsigned)(R * RB + C * 2); voffB[i] = (unsigned)(Rb * RB + C * 2); rowA[i] = R; colA2[i] = C * 2; }
    unsigned gc[2][2], gn[2][2];
#define PG8_GOFF(u_, go_) do { const int e_ = (u_).pn / GI.npn; const int base_ = (u_).pm * BM - GI.tab[e_]; const int cnt_ = GI.tab[64 + e_]; const LAS int* rp_ = GI.rp + e_ * GI.nrep; \
        _Pragma("unroll") for (int h_ = 0; h_ < 2; ++h_) _Pragma("unroll") for (int i_ = 0; i_ < 2; ++i_) { const int ii_ = base_ + 128 * h_ + rowA[i_]; int r_ = 0; \
            for (int j_ = 1; j_ < GI.nrep; ++j_) r_ += (rp_[j_] <= ii_) ? 1 : 0; \
            const int tok_ = ii_ < cnt_ ? GI.elist[((size_t)e_ * GI.nrep + r_) * GI.rcap + (ii_ - rp_[r_])] : 0; go_[h_][i_] = (unsigned)tok_ * (unsigned)RB + (unsigned)colA2[i_]; } } while (0)
#define PG8_STAGE_G(bufoff, go_, kb_) do { _Pragma("unroll") for (int _i = 0; _i < 2; ++_i) \
        __builtin_amdgcn_global_load_lds((const unsigned*)((const char*)g.A + (go_)[_i] + (kb_)), (LAS unsigned*)(lds + (bufoff) + ldsw + _i * 8192), 16, 0, 0); } while (0)
#define PG8_STAGE_A(bufoff, ptr_, h_, usenext_, kb_) do { if constexpr (GATHER) { unsigned o_[2] = { (usenext_) ? gn[h_][0] : gc[h_][0], (usenext_) ? gn[h_][1] : gc[h_][1] }; PG8_STAGE_G(bufoff, o_, kb_); } else { PG8_STAGE(bufoff, ptr_, voffA); } } while (0)
    const size_t kstep = 128;
    const size_t hstep = (size_t)HALF * RB;
    const size_t tstep = 2 * hstep;
    const unsigned ldsw = (unsigned)wid * 1024u;
    const int aoff = lds_byte(wr * 64 + fr, fq * 8), boff = lds_byte(wc * 32 + fr, fq * 8);
#define PG8_SA(b, h) (((b) * 2 + (h)) * HTB)
#define PG8_SB(b, h) ((4 + (b) * 2 + (h)) * HTB)
#define PG8_STAGE(bufoff, gbase, voff) do { _Pragma("unroll") for (int _i = 0; _i < 2; ++_i) \
        __builtin_amdgcn_global_load_lds((const unsigned*)((const char*)(gbase) + (voff)[_i]), (LAS unsigned*)(lds + (bufoff) + ldsw + _i * 8192), 16, 0, 0); } while (0)
    const LAS unsigned char* rdA = lds + aoff; const LAS unsigned char* rdB = lds + 4 * HTB + boff; asm volatile("" : "+v"(rdA), "+v"(rdB));
#define PG8_LD16A(off) (*(const LAS i32x4*)(rdA + (off)))
#define PG8_LD16B(off) (*(const LAS i32x4*)(rdB + (off)))
#define PG8_LDA(dst, b, h) do { _Pragma("unroll") for (int m = 0; m < 4; ++m) dst[m] = __builtin_shufflevector(PG8_LD16A(PG8_SA(b, h) + m * 2048), PG8_LD16A(PG8_SA(b, h) + m * 2048 + 1024), 0, 1, 2, 3, 4, 5, 6, 7); } while (0)
#define PG8_LDB(dst, b, h) do { _Pragma("unroll") for (int n = 0; n < 2; ++n) dst[n] = __builtin_shufflevector(PG8_LD16B(PG8_SB(b, h) - 4 * HTB + n * 2048), PG8_LD16B(PG8_SB(b, h) - 4 * HTB + n * 2048 + 1024), 0, 1, 2, 3, 4, 5, 6, 7); } while (0)
#define PG8_LO(x) __builtin_bit_cast(bf16x8, __builtin_shufflevector(x, x, 0, 1, 2, 3))
#define PG8_HI(x) __builtin_bit_cast(bf16x8, __builtin_shufflevector(x, x, 4, 5, 6, 7))
#define PG8_MMA(ai, bj, At, Bt) do { __builtin_amdgcn_s_setprio(1); _Pragma("unroll") for (int m = 0; m < 4; ++m) _Pragma("unroll") for (int n = 0; n < 2; ++n) { \
        if constexpr (FP8) asm volatile("v_mfma_scale_f32_16x16x128_f8f6f4 %0, %1, %2, %0, %3, %3 op_sel_hi:[0,0,0]" : "+v"(acc[ai][bj][m][n]) : "v"(Bt[n]), "v"(At[m]), "v"(sc1)); \
        else { acc[ai][bj][m][n] = __builtin_amdgcn_mfma_f32_16x16x32_bf16(PG8_LO(Bt[n]), PG8_LO(At[m]), acc[ai][bj][m][n], 0, 0, 0); \
               acc[ai][bj][m][n] = __builtin_amdgcn_mfma_f32_16x16x32_bf16(PG8_HI(Bt[n]), PG8_HI(At[m]), acc[ai][bj][m][n], 0, 0, 0); } } \
        __builtin_amdgcn_s_setprio(0); } while (0)
#define PG8_WAIT_V(n) asm volatile("s_waitcnt vmcnt(" #n ")" ::: "memory")
#define PG8_WAIT_L(n) asm volatile("s_waitcnt lgkmcnt(" #n ")" ::: "memory")
#define PG8_BAR __builtin_amdgcn_s_barrier()
#define PG8_SCHED __builtin_amdgcn_sched_barrier(0)
    Unit cur, nxt; int ui = 0;
    if (!S.next(0, cur)) return;
    f32x4 acc[2][2][4][2];
#pragma unroll
    for (int a = 0; a < 2; ++a)
#pragma unroll
        for (int b = 0; b < 2; ++b)
#pragma unroll
            for (int m = 0; m < 4; ++m)
#pragma unroll
                for (int n = 0; n < 2; ++n) acc[a][b][m][n] = (f32x4){0.f, 0.f, 0.f, 0.f};
    const int sc1 = 0x7f7f7f7f;
    i32x8 At[4], B0[2], B1[2];
    const char* cA = (const char*)g.A + (size_t)cur.pm * tstep; const char* cB = (const char*)g.Bt + (size_t)cur.pn * tstep;
    S.a_ready(cur);
    if constexpr (GATHER) { PG8_GOFF(cur, gc); }
    {
        PG8_STAGE(PG8_SB(0, 0), cB, voffB); PG8_STAGE(PG8_SB(0, 1), cB + hstep, voffB); PG8_STAGE_A(PG8_SA(0, 0), cA, 0, false, 0); PG8_STAGE_A(PG8_SA(0, 1), cA + hstep, 1, false, 0);
        if (wr == 1) PG8_BAR;
        PG8_WAIT_V(2); PG8_BAR;
        PG8_STAGE(PG8_SB(1, 0), cB + kstep, voffB); PG8_STAGE_A(PG8_SA(1, 0), cA + kstep, 0, false, 128); PG8_STAGE(PG8_SB(1, 1), cB + hstep + kstep, voffB);
        PG8_WAIT_V(6); PG8_BAR;
    }
    for (;;) {
        const bool has_next = S.next(ui + 1, nxt);
        const char* nA = has_next ? (const char*)g.A + (size_t)nxt.pm * tstep : cA; const char* nB = has_next ? (const char*)g.Bt + (size_t)nxt.pn * tstep : cB;
        if constexpr (GATHER) { if (has_next) { PG8_GOFF(nxt, gn); } else { gn[0][0] = gc[0][0]; gn[0][1] = gc[0][1]; gn[1][0] = gc[1][0]; gn[1][1] = gc[1][1]; } }
        for (int t = 0; t < nt; t += 2) {
            const bool last = (t == nt - 2);
            const char* a1 = cA + (size_t)(t + 1) * kstep;
            const char* a2 = last ? nA : cA + (size_t)(t + 2) * kstep; const char* b2 = last ? nB : cB + (size_t)(t + 2) * kstep;
            const char* a3 = a2 + kstep; const char* b3 = b2 + kstep;
            if (last && has_next) S.a_ready(nxt);
            PG8_LDB(B0, 0, 0); PG8_LDB(B1, 0, 1); PG8_SCHED; PG8_LDA(At, 0, 0); PG8_STAGE_A(PG8_SA(1, 1), a1 + hstep, 1, false, (unsigned)(t + 1) * 128u);
            PG8_WAIT_V(8); PG8_WAIT_L(0); PG8_BAR; PG8_MMA(0, 0, At, B0); PG8_MMA(0, 1, At, B1); PG8_BAR; PG8_SCHED;
            PG8_LDA(At, 0, 1); PG8_STAGE(PG8_SB(0, 0), b2, voffB); PG8_STAGE(PG8_SB(0, 1), b2 + hstep, voffB); PG8_STAGE_A(PG8_SA(0, 0), a2, 0, last, last ? 0u : (unsigned)(t + 2) * 128u);
            PG8_WAIT_V(8); PG8_WAIT_L(0); PG8_BAR; PG8_MMA(1, 0, At, B0); PG8_MMA(1, 1, At, B1); PG8_BAR; PG8_SCHED;
            PG8_LDB(B0, 1, 0); PG8_LDB(B1, 1, 1); PG8_SCHED; PG8_LDA(At, 1, 0); PG8_STAGE_A(PG8_SA(0, 1), a2 + hstep, 1, last, last ? 0u : (unsigned)(t + 2) * 128u);
            PG8_WAIT_V(8); PG8_WAIT_L(0); PG8_BAR; PG8_MMA(0, 0, At, B0); PG8_MMA(0, 1, At, B1); PG8_BAR; PG8_SCHED;
            PG8_LDA(At, 1, 1); PG8_STAGE(PG8_SB(1, 0), b3, voffB); PG8_STAGE(PG8_SB(1, 1), b3 + hstep, voffB); PG8_STAGE_A(PG8_SA(1, 0), a3, 0, last, last ? 128u : (unsigned)(t + 3) * 128u);
            PG8_WAIT_V(8); PG8_WAIT_L(0); PG8_BAR; PG8_MMA(1, 0, At, B0); PG8_MMA(1, 1, At, B1); PG8_BAR; PG8_SCHED;
        }
        if constexpr (ALIGN_EPI) { if (wr == 0) PG8_BAR; }
        if constexpr (FP8) asm volatile("s_nop 15\n\ts_nop 15" ::: "memory");
        E(acc, cur, wr, wc, fr, fq); S.done(cur);
        if (!has_next) break;
#pragma unroll
        for (int a = 0; a < 2; ++a)
#pragma unroll
            for (int b = 0; b < 2; ++b)
#pragma unroll
                for (int m = 0; m < 4; ++m)
#pragma unroll
                    for (int n = 0; n < 2; ++n) acc[a][b][m][n] = (f32x4){0.f, 0.f, 0.f, 0.f};
        cur = nxt; cA = nA; cB = nB; ++ui;
        if constexpr (GATHER) { gc[0][0] = gn[0][0]; gc[0][1] = gn[0][1]; gc[1][0] = gn[1][0]; gc[1][1] = gn[1][1]; }
        if constexpr (ALIGN_EPI) { if (wr == 1) PG8_BAR; }
    }
    PG8_WAIT_V(0);
    if constexpr (!ALIGN_EPI) { if (wr == 0) PG8_BAR; }
    PG8_BAR;
#undef PG8_SA
#undef PG8_SB
#undef PG8_STAGE
#undef PG8_STAGE_G
#undef PG8_STAGE_A
#undef PG8_GOFF
#undef PG8_LDA
#undef PG8_LD16A
#undef PG8_LD16B
#undef PG8_LO
#undef PG8_HI
#undef PG8_LDB
#undef PG8_MMA
#undef PG8_WAIT_V
#undef PG8_WAIT_L
#undef PG8_BAR
#undef PG8_SCHED
}
}

constexpr int D = 2048, NB = 4, T = 4096, TC = 256;
constexpr int M_LAT = NB * T, M_CTX = NB * TC, M_ALL = M_LAT + M_CTX;
constexpr int DC = 1024, DR = 1024, HS = 64, NH = 16, WL = 64, AL = 64, GL = 160;
constexpr int P_STATE = 2304, P_RWKV = 3488, P_IN = 6560, P_PAD = 6720, Q0 = 3 * DC;
constexpr int NE = 32, TOPK = 4, DE = 2048, EB = 256;
constexpr int MAXBLK = (M_LAT * TOPK) / EB + NE, NSLOT = MAXBLK * EB;
constexpr int NMOD = 6 * D;
constexpr float RMS_EPS = 1e-6f, LNX_EPS = 64e-5f, KK_EPS = 1e-24f;
constexpr int NWAVES = 8, NTHR = 512;
constexpr int RR = 16, RCAP = 2048;
constexpr float WSCALE = 64.0f;
constexpr int LOWW = 2 * WL + 2 * AL + GL, LOWP = LOWW + 8;

constexpr size_t MiB = 1u << 20;
constexpr size_t WS_CTL = 0, CTL_ZERO_BYTES = 1 * MiB;
constexpr size_t WS_MOD = 1 * MiB;
constexpr size_t WS_WIN = 2 * MiB;
constexpr size_t WS_WOUT = 28 * MiB;
constexpr size_t WS_WGU = 36 * MiB;
constexpr size_t WS_WDN = 548 * MiB;
constexpr size_t WS_H = 804 * MiB;
constexpr size_t WS_P = 872 * MiB;
constexpr size_t WS_SC = 1096 * MiB, SC_STRIDE = 68 * MiB;
constexpr size_t WS_SB = WS_SC + 2 * SC_STRIDE, SB_STRIDE = 34 * MiB;
enum { SB_KD = 0, SB_BB = 2, SB_NKK = 4, SB_V = 5, SB_R = 6 };
constexpr size_t WS_G = WS_SC + 9 * SC_STRIDE;
constexpr size_t WS_Y = WS_G + 64 * MiB;
constexpr size_t WS_MIXIN = WS_Y + 128 * MiB;
constexpr size_t WS_MIX = WS_MIXIN + 64 * MiB;
constexpr size_t WS_X1 = WS_MIX + 128 * MiB;
constexpr size_t WS_H2 = WS_X1 + 128 * MiB;
constexpr size_t WS_ROUTE = WS_H2 + 64 * MiB;
constexpr size_t WS_MODP = WS_ROUTE + 7 * MiB;
constexpr size_t WS_WT = WS_ROUTE + 6 * MiB;
constexpr size_t WS_XG = WS_ROUTE + 8 * MiB;
constexpr size_t WS_ACT = WS_XG + 288 * MiB;
constexpr size_t WS_YM = WS_ACT + 288 * MiB;
constexpr size_t WS_END = WS_YM + 288 * MiB;
constexpr int CW_TMO = 0, CW_BAR = 4096, CW_CNT = 8192;

constexpr int RING_BYTES = 131072, MISC_OFF = RING_BYTES, TAB_OFF = RING_BYTES + 256, RP_OFF = RING_BYTES + 768, LIST_OFF = RING_BYTES + 3072, STG_OFF = RING_BYTES + 4096, LDS_BYTES = STG_OFF + 32 * 528;

#define XB_TMO      128
#define XB_XCNT(j)  (256  + 64 * (j))
#define XB_XSUB(j)  (1280 + 64 * (j))
#define XB_XGEN(j)  (2304 + 64 * (j))
#define XB_TOP      3328
#define XB_TOPGEN   3392
#define XCD_BAR_WORDS 3456
#define XB_SPIN_CAP (1u << 18)
__device__ __forceinline__ unsigned xb_ld(unsigned* p)              { return __hip_atomic_load(p, __ATOMIC_RELAXED, __HIP_MEMORY_SCOPE_AGENT); }
__device__ __forceinline__ unsigned xb_add(unsigned* p, unsigned v) { return __hip_atomic_fetch_add(p, v, __ATOMIC_RELAXED, __HIP_MEMORY_SCOPE_AGENT); }
__device__ __forceinline__ unsigned xb_xcc_id() { return (unsigned)__builtin_amdgcn_s_getreg((3 << 11) | 20) & 0xFu; }
#define XB_SPIN(cond, bar) do { unsigned _sp = 0; while (cond) { __builtin_amdgcn_s_sleep(1); \
    if ((++_sp & 255u) == 0u) { if (xb_ld(&(bar)[XB_TMO])) break; if (_sp > XB_SPIN_CAP) { atomicAdd(&(bar)[XB_TMO], 1u); break; } } } } while (0)
struct XcdBarrier { unsigned* bar; unsigned x; volatile LAS unsigned* st; };
__device__ __forceinline__ XcdBarrier xcd_barrier_post(unsigned* bar, volatile LAS unsigned* st) {
    XcdBarrier b; b.bar = bar; b.x = xb_xcc_id(); b.st = st;
    if (threadIdx.x == 0) (void)xb_add(&bar[XB_XCNT(b.x)], 1u);
    return b;
}
__device__ __forceinline__ void xcd_barrier_complete(unsigned* bar, unsigned x, unsigned& nloc, unsigned& nx) {
    const unsigned G = gridDim.x * gridDim.y * gridDim.z;
    unsigned sum, cnt, mine, sp = 0u;
    for (;;) {
        sum = 0u; cnt = 0u; mine = 0u;
#pragma unroll
        for (unsigned j = 0; j < 16; ++j) { const unsigned c = xb_ld(&bar[XB_XCNT(j)]); sum += c; cnt += (c > 0u) ? 1u : 0u; mine = (j == x) ? c : mine; }
        if (sum == G) break;
        __builtin_amdgcn_s_sleep(1);
        if ((++sp & 255u) == 0u) { if (xb_ld(&bar[XB_TMO])) break; if (sp > XB_SPIN_CAP) { atomicAdd(&bar[XB_TMO], 1u); break; } }
    }
    nloc = mine > 0u ? mine : 1u; nx = cnt > 0u ? cnt : 1u;
}
__device__ __forceinline__ void xcd_barrier(const XcdBarrier& b) {
    asm volatile("s_waitcnt vmcnt(0)" ::: "memory");
    __syncthreads();
    if (threadIdx.x == 0) {
        unsigned* bar = b.bar;
        __builtin_amdgcn_s_waitcnt(0);
        unsigned nloc = b.st[0], nx = b.st[1];
        if (nloc == 0u) { xcd_barrier_complete(bar, b.x, nloc, nx); b.st[0] = nloc; b.st[1] = nx; }
        const unsigned old = xb_add(&bar[XB_XSUB(b.x)], 1u);
        const unsigned gen = old / nloc;
        if (old + 1u == (gen + 1u) * nloc) {
            __builtin_amdgcn_fence(__ATOMIC_RELEASE, "agent");
            asm volatile("s_waitcnt vmcnt(0)" ::: "memory");
            const unsigned og = xb_add(&bar[XB_TOP], 1u);
            const unsigned tg = og / nx;
            if (og + 1u == (tg + 1u) * nx) xb_add(&bar[XB_TOPGEN], 1u);
            else XB_SPIN(xb_ld(&bar[XB_TOPGEN]) == tg, bar);
            __builtin_amdgcn_fence(__ATOMIC_ACQUIRE, "agent");
            xb_add(&bar[XB_XGEN(b.x)], 1u);
            asm volatile("s_waitcnt vmcnt(0)" ::: "memory");
        } else {
            XB_SPIN(xb_ld(&bar[XB_XGEN(b.x)]) == gen, bar);
            __builtin_amdgcn_fence(__ATOMIC_ACQUIRE, "agent");
            asm volatile("s_waitcnt vmcnt(0)" ::: "memory");
        }
    }
    __syncthreads();
}

struct Frame {
    LAS unsigned char* lds;
    int tid, lane, wave, G, bx;
    const float* in[27];
    float* out; unsigned char* ws;
};
#define IN_X        (F.in[0])
#define IN_C        (F.in[1])
#define IN_CTX      (F.in[2])
#define IN_CCTX     (F.in[3])
#define IN_WMOD     (F.in[4])
#define IN_BMOD     (F.in[5])
#define IN_NORMG    (F.in[6])
#define IN_WIN      (F.in[7])
#define IN_CONVW    (F.in[8])
#define IN_MU       (F.in[9])
#define IN_W0       (F.in[10])
#define IN_WUP      (F.in[11])
#define IN_A0       (F.in[12])
#define IN_AUP      (F.in[13])
#define IN_KK       (F.in[14])
#define IN_KA       (F.in[15])
#define IN_RK       (F.in[16])
#define IN_LNXW     (F.in[17])
#define IN_LNXB     (F.in[18])
#define IN_GUP      (F.in[19])
#define IN_WOUT     (F.in[20])
#define IN_WROUTER  (F.in[21])
#define IN_BROUTER  (F.in[22])
#define IN_WGU      (F.in[23])
#define IN_BGU      (F.in[24])
#define IN_WDN      (F.in[25])
#define IN_BDN      (F.in[26])
#define WSP(T_, off) ((T_*)(F.ws + (off)))

#define LDS_WAIT() asm volatile("s_waitcnt lgkmcnt(0)" ::: "memory")
__device__ __forceinline__ float bf2f(bf16_t v) { return __builtin_bit_cast(float, (unsigned)v << 16); }
__device__ __forceinline__ unsigned f2bf(float f) { unsigned u = __builtin_bit_cast(unsigned, f); return (u + 0x7fffu + ((u >> 16) & 1u)) >> 16; }
__device__ __forceinline__ unsigned pk2(float lo, float hi) { return f2bf(lo) | (f2bf(hi) << 16); }
__device__ __forceinline__ float wave_sum(float v) {
#pragma unroll
    for (int o = 1; o < 64; o <<= 1) v += __shfl_xor(v, o);
    return v;
}
__device__ __forceinline__ float sigmoidf_(float x) { return __builtin_amdgcn_rcpf(1.0f + __expf(-x)); }

struct TrTile { const float* src; unsigned char* dst; int N, ncols, fp8; };
__device__ __forceinline__ TrTile p0_decode(Frame& F, int it) {
    constexpr int T_IN = 16 * (P_PAD / 256);
    const bool is_in = it < T_IN; const int r = is_in ? it : it - T_IN;
    const float* W = is_in ? IN_WIN : IN_WOUT; unsigned char* WT = is_in ? WSP(unsigned char, WS_WIN) : WSP(unsigned char, WS_WOUT); const int N = is_in ? P_IN : D;
    const int nblk = (N + 255) / 256, kb = r / nblk, nb = r % nblk;
    TrTile t; t.src = W + (size_t)(128 * kb) * N + 256 * nb; t.dst = WT + ((size_t)(256 * nb) * D + 128 * kb) * 2; t.N = N; t.ncols = (N - 256 * nb) < 256 ? (N - 256 * nb) : 256; t.fp8 = 0; return t;
}
#define P0_LOAD(v, t) do { const bool _ok = 4 * F.lane < (t).ncols; const float* _s = (t).src + (size_t)(16 * F.wave) * (t).N + 4 * F.lane; \
    _Pragma("unroll") for (int i = 0; i < 16; ++i) v[i] = _ok ? *(const f32x4*)(_s + (size_t)i * (t).N) : (f32x4){0.f, 0.f, 0.f, 0.f}; } while (0)
__device__ __forceinline__ void p0_store_tile(Frame& F, const f32x4 (&v)[16], const TrTile& t) {
    LAS unsigned char* tile = F.lds;
    if (t.fp8) {
#pragma unroll
        for (int j = 0; j < 4; ++j) { const int n = 4 * F.lane + j; u32x4 w;
            w.x = pg8::pk4_fp8(v[0][j] * WSCALE, v[1][j] * WSCALE, v[2][j] * WSCALE, v[3][j] * WSCALE); w.y = pg8::pk4_fp8(v[4][j] * WSCALE, v[5][j] * WSCALE, v[6][j] * WSCALE, v[7][j] * WSCALE);
            w.z = pg8::pk4_fp8(v[8][j] * WSCALE, v[9][j] * WSCALE, v[10][j] * WSCALE, v[11][j] * WSCALE); w.w = pg8::pk4_fp8(v[12][j] * WSCALE, v[13][j] * WSCALE, v[14][j] * WSCALE, v[15][j] * WSCALE);
            *(LAS u32x4*)(tile + n * 128 + ((F.wave ^ ((n >> 2) & 7)) << 4)) = w; }
        __syncthreads();
#pragma unroll
        for (int j = 0; j < 4; ++j) { const int n = 32 * F.wave + (F.lane >> 3) + 8 * j, c = F.lane & 7;
            if (n < t.ncols) *(u32x4*)(t.dst + (size_t)n * D + 16 * c) = *(const LAS u32x4*)(tile + n * 128 + ((c ^ ((n >> 2) & 7)) << 4)); }
        __syncthreads();
        return;
    }
#pragma unroll
    for (int j = 0; j < 4; ++j) { const int n = 4 * F.lane + j;
#pragma unroll
        for (int hc = 0; hc < 2; ++hc) { u32x4 w;
            w.x = pg8::cvt_pk_bf16(v[8 * hc + 0][j], v[8 * hc + 1][j]); w.y = pg8::cvt_pk_bf16(v[8 * hc + 2][j], v[8 * hc + 3][j]);
            w.z = pg8::cvt_pk_bf16(v[8 * hc + 4][j], v[8 * hc + 5][j]); w.w = pg8::cvt_pk_bf16(v[8 * hc + 6][j], v[8 * hc + 7][j]);
            *(LAS u32x4*)(tile + n * 256 + (((2 * F.wave + hc) ^ ((n >> 2) & 15)) << 4)) = w; } }
    __syncthreads();
#pragma unroll
    for (int j = 0; j < 8; ++j) { const int n = 32 * F.wave + (F.lane >> 4) + 4 * j, c = F.lane & 15;
        if (n < t.ncols) *(u32x4*)(t.dst + ((size_t)n * D + 8 * c) * 2) = *(const LAS u32x4*)(tile + n * 256 + ((c ^ ((n >> 2) & 15)) << 4)); }
    __syncthreads();
}
__device__ __forceinline__ void p0_prologue(Frame& F) {
    for (int u = F.bx; u < (NMOD / 256) * 4; u += F.G) {
        const int nb = u >> 2, kq = u & 3;
        LAS float* sl = (LAS float*)F.lds;
        LAS float* red = (LAS float*)(F.lds + 16384);
        __syncthreads();
        for (int i = F.tid; i < 5 * 512; i += NTHR) { const int r = i >> 9, k = 512 * kq + (i & 511); const float cv = r < 4 ? IN_C[r * D + k] : IN_CCTX[k]; sl[i] = cv / (1.0f + __expf(-cv)); }
        __syncthreads();
        f32x4 acc[5];
#pragma unroll
        for (int r = 0; r < 5; ++r) acc[r] = (f32x4){0.f, 0.f, 0.f, 0.f};
        const int kl = F.wave * 64;
        const float* wp = IN_WMOD + (size_t)(512 * kq + kl) * NMOD + nb * 256 + F.lane * 4;
#pragma unroll 16
        for (int k = 0; k < 64; ++k) { const f32x4 w = *(const f32x4*)(wp + (size_t)k * NMOD);
#pragma unroll
            for (int r = 0; r < 5; ++r) acc[r] += sl[r * 512 + kl + k] * w; }
#pragma unroll
        for (int r = 0; r < 5; ++r) *(LAS f32x4*)(red + (F.wave * 5 + r) * 256 + F.lane * 4) = acc[r];
        __syncthreads();
        float* modp = WSP(float, WS_MODP) + (size_t)kq * 5 * NMOD;
        for (int o = F.tid; o < 5 * 256; o += NTHR) { const int r = o / 256, col = o % 256; float s = 0.f;
#pragma unroll
            for (int w = 0; w < 8; ++w) s += red[(w * 5 + r) * 256 + col];
            modp[r * NMOD + nb * 256 + col] = s; }
        __syncthreads();
    }
    {
        constexpr int NTILES = 16 * (P_PAD / 256) + 16 * (D / 256);
        f32x4 va[16], vb[16];
        int it = F.bx;
        TrTile ta, tb; ta = p0_decode(F, it < NTILES ? it : 0); tb = ta;
        if (it < NTILES) P0_LOAD(va, ta);
        while (it < NTILES) {
            const int it1 = it + F.G;
            if (it1 < NTILES) { tb = p0_decode(F, it1); P0_LOAD(vb, tb); }
            p0_store_tile(F, va, ta);
            if (it1 >= NTILES) break;
            const int it2 = it1 + F.G;
            if (it2 < NTILES) { ta = p0_decode(F, it2); P0_LOAD(va, ta); }
            p0_store_tile(F, vb, tb);
            it = it2;
        }
    }
    {
        bf16_t* WT = WSP(bf16_t, WS_WT);
        for (int idx = F.bx * NTHR + F.tid; idx < LOWW * DR; idx += F.G * NTHR) { const int j = idx / DR, c = idx % DR;
            const float v = j < 128 ? IN_WUP[(size_t)j * DR + c] : j < 256 ? IN_AUP[(size_t)(j - 128) * DR + c] : IN_GUP[(size_t)(j - 256) * DR + c];
            WT[(size_t)c * LOWW + j] = (bf16_t)f2bf(v); }
    }
}

__device__ __forceinline__ void p1_norm(Frame& F) {
    const float* modp = WSP(float, WS_MODP); float* mod = WSP(float, WS_MOD); bf16_t* H = WSP(bf16_t, WS_H);
    for (int idx = F.bx * NTHR + F.tid; idx < 5 * NMOD; idx += F.G * NTHR)
        mod[idx] = ((modp[idx] + modp[5 * NMOD + idx]) + (modp[2 * 5 * NMOD + idx] + modp[3 * 5 * NMOD + idx])) + IN_BMOD[idx % NMOD];
    LAS float* gs = (LAS float*)F.lds;
    LAS float* sh = gs + D;
    const int rpw = (M_ALL + F.G - 1) / F.G, r0 = F.bx * rpw, r1 = (r0 + rpw) < M_ALL ? (r0 + rpw) : M_ALL;
    int cur = -1;
    for (int rb = r0; rb < r1; rb += NWAVES) {
        const int b0 = rb < M_LAT ? rb / T : 4;
        if (b0 != cur) {
            __syncthreads();
            for (int c = F.tid; c < D; c += NTHR) { const int i0 = b0 * NMOD + c, i1 = b0 * NMOD + D + c;
                const float shv = ((modp[i0] + modp[5 * NMOD + i0]) + (modp[2 * 5 * NMOD + i0] + modp[3 * 5 * NMOD + i0])) + IN_BMOD[c];
                const float scv = ((modp[i1] + modp[5 * NMOD + i1]) + (modp[2 * 5 * NMOD + i1] + modp[3 * 5 * NMOD + i1])) + IN_BMOD[D + c];
                gs[c] = IN_NORMG[c] * (1.0f + scv); sh[c] = shv; }
            __syncthreads();
            cur = b0;
        }
        const int row = rb + F.wave;
        const int bw = row < M_LAT ? row / T : 4;
        if (row < r1 && bw == b0) {
            const float* xr = row < M_LAT ? IN_X + (size_t)row * D : IN_CTX + (size_t)(row - M_LAT) * D;
            f32x4 v[8]; float ss = 0.f;
#pragma unroll
            for (int j = 0; j < 8; ++j) { v[j] = *(const f32x4*)(xr + 4 * F.lane + 256 * j); ss += (v[j].x * v[j].x + v[j].y * v[j].y) + (v[j].z * v[j].z + v[j].w * v[j].w); }
            const float rstd = 1.0f / sqrtf(wave_sum(ss) * (1.0f / D) + RMS_EPS);
#pragma unroll
            for (int j = 0; j < 8; ++j) { const int c = 4 * F.lane + 256 * j;
                const f32x4 o = (v[j] * rstd) * *(const LAS f32x4*)(gs + c) + *(const LAS f32x4*)(sh + c);
                u32x2 w; w.x = pg8::cvt_pk_bf16(o.x, o.y); w.y = pg8::cvt_pk_bf16(o.z, o.w);
                *(u32x2*)(H + (size_t)row * D + c) = w; }
        }
        if (rb + NWAVES - 1 < r1 || true) { const int lastrow = (rb + NWAVES - 1) < r1 ? (rb + NWAVES - 1) : (r1 - 1); const int bl = lastrow < M_LAT ? lastrow / T : 4;
            if (bl != b0) {
                __syncthreads();
                for (int c = F.tid; c < D; c += NTHR) { const int i0 = bl * NMOD + c, i1 = bl * NMOD + D + c;
                    const float shv = ((modp[i0] + modp[5 * NMOD + i0]) + (modp[2 * 5 * NMOD + i0] + modp[3 * 5 * NMOD + i0])) + IN_BMOD[c];
                    const float scv = ((modp[i1] + modp[5 * NMOD + i1]) + (modp[2 * 5 * NMOD + i1] + modp[3 * 5 * NMOD + i1])) + IN_BMOD[D + c];
                    gs[c] = IN_NORMG[c] * (1.0f + scv); sh[c] = shv; }
                __syncthreads();
                cur = bl;
                if (row < r1 && bw == bl) {
                    const float* xr = row < M_LAT ? IN_X + (size_t)row * D : IN_CTX + (size_t)(row - M_LAT) * D;
                    f32x4 v[8]; float ss = 0.f;
#pragma unroll
                    for (int j = 0; j < 8; ++j) { v[j] = *(const f32x4*)(xr + 4 * F.lane + 256 * j); ss += (v[j].x * v[j].x + v[j].y * v[j].y) + (v[j].z * v[j].z + v[j].w * v[j].w); }
                    const float rstd = 1.0f / sqrtf(wave_sum(ss) * (1.0f / D) + RMS_EPS);
#pragma unroll
                    for (int j = 0; j < 8; ++j) { const int c = 4 * F.lane + 256 * j;
                        const f32x4 o = (v[j] * rstd) * *(const LAS f32x4*)(gs + c) + *(const LAS f32x4*)(sh + c);
                        u32x2 w; w.x = pg8::cvt_pk_bf16(o.x, o.y); w.y = pg8::cvt_pk_bf16(o.z, o.w);
                        *(u32x2*)(H + (size_t)row * D + c) = w; }
                }
            }
        }
    }
}

__device__ __forceinline__ void static_unit(int L, int nM, int nN, int& pm, int& pn) {
    const int nwg = nM * nN; int wgid = L;
    { const int q = nwg / 8, r = nwg % 8, xcd = wgid % 8, off = wgid / 8; wgid = (xcd < r ? xcd * (q + 1) : r * (q + 1) + (xcd - r) * q) + off; }
    const int nig = 8 * nN, gid = wgid / nig, fm = gid * 8, gsz = (nM - fm) < 8 ? (nM - fm) : 8;
    pm = fm + ((wgid % nig) % gsz); pn = (wgid % nig) / gsz;
}
__device__ __forceinline__ void build_tab(Frame& F) {
    LAS int* tab = (LAS int*)(F.lds + TAB_OFF); LAS int* rp = (LAS int*)(F.lds + RP_OFF);
    if (F.tid < NE) { const unsigned* cnt = WSP(unsigned, WS_CTL) + CW_CNT; int run = 0;
#pragma unroll
        for (int r = 0; r < RR; ++r) { rp[F.tid * RR + r] = run; run += (int)__hip_atomic_load(cnt + (r * NE + F.tid) * 16, __ATOMIC_RELAXED, __HIP_MEMORY_SCOPE_AGENT); }
        tab[64 + F.tid] = run; }
    __syncthreads();
    if (F.tid == 0) { int run = 0;
        for (int e = 0; e < NE; ++e) { tab[e] = run; run += ((tab[64 + e] + EB - 1) / EB) * EB; }
        tab[32] = run; }
    __syncthreads();
}
__device__ __forceinline__ int build_list(Frame& F, int mode) {
    LAS int* list = (LAS int*)(F.lds + LIST_OFF); const LAS int* tab = (const LAS int*)(F.lds + TAB_OFF);
    int total;
    if (mode == 0) total = 64 * 26 + 4 * 9; else if (mode == 1) total = 64 * 8; else total = (tab[32] / EB) * (mode == 2 ? 16 : 8);
    const int c = F.bx; const int n = c < total ? (total - c + F.G - 1) / F.G : 0;
    if (F.tid < n && F.tid < 64) {
        const int L = F.tid * F.G + c; int pm, pn;
        if (mode == 0) { if (L < 64 * 26) static_unit(L, 64, 26, pm, pn); else { const int r = L - 64 * 26; pm = 64 + (r & 3); pn = 12 + (r >> 2); } }
        else if (mode == 1) static_unit(L, 64, 8, pm, pn);
        else { const int NT = mode == 2 ? 16 : 8; int wgid = L;
            { const int q = total / 8, r = total % 8, xcd = wgid % 8, off = wgid / 8; wgid = (xcd < r ? xcd * (q + 1) : r * (q + 1) + (xcd - r) * q) + off; }
            int e = 0, ustart = 0;
            for (; e < NE - 1; ++e) { const int nb = (tab[e + 1] - tab[e]) / EB; if (wgid < ustart + nb * NT) break; ustart += nb * NT; }
            const int nb = (tab[e + 1] - tab[e]) / EB, re = wgid - ustart, j = re / (8 * NT), r = re - j * 8 * NT, gsz = (nb - 8 * j) < 8 ? (nb - 8 * j) : 8;
            pm = tab[e] / EB + 8 * j + r % gsz; pn = e * NT + r / gsz; }
        list[2 * F.tid] = pm; list[2 * F.tid + 1] = pn;
    }
    __syncthreads();
    return n < 64 ? n : 64;
}

__device__ __forceinline__ float qshift(const bf16_t* p, int gr, int s0, int s1, int col, float mu0, float mu1) {
    const float c = bf2f(p[(size_t)gr * P_PAD + Q0 + col]);
    const float pv = gr > s0 ? bf2f(p[(size_t)(gr - 1) * P_PAD + Q0 + col]) : 0.f;
    const float nx = gr + 1 < s1 ? bf2f(p[(size_t)(gr + 1) * P_PAD + Q0 + col]) : 0.f;
    return c + mu0 * (pv - c) + mu1 * (nx - c);
}
__device__ __forceinline__ f32x4 ld_bf4(const bf16_t* p) { const u32x2 w = *(const u32x2*)p; return (f32x4){__builtin_bit_cast(float, w.x << 16), __builtin_bit_cast(float, w.x & 0xffff0000u), __builtin_bit_cast(float, w.y << 16), __builtin_bit_cast(float, w.y & 0xffff0000u)}; }
__device__ __forceinline__ void ld_bf8(const bf16_t* p, f32x4& lo, f32x4& hi) { const u32x4 w = *(const u32x4*)p;
    lo = (f32x4){__builtin_bit_cast(float, w.x << 16), __builtin_bit_cast(float, w.x & 0xffff0000u), __builtin_bit_cast(float, w.y << 16), __builtin_bit_cast(float, w.y & 0xffff0000u)};
    hi = (f32x4){__builtin_bit_cast(float, w.z << 16), __builtin_bit_cast(float, w.z & 0xffff0000u), __builtin_bit_cast(float, w.w << 16), __builtin_bit_cast(float, w.w & 0xffff0000u)}; }
__device__ __forceinline__ f32x4 qshift4(const bf16_t* P, const float* mu, int gr, bool hp, bool hn, int col) {
    const bf16_t* pr = P + (size_t)gr * P_PAD + Q0 + col;
    const f32x4 c = ld_bf4(pr); const f32x4 z = (f32x4){0.f, 0.f, 0.f, 0.f};
    const f32x4 pv = hp ? ld_bf4(pr - P_PAD) : z, nx = hn ? ld_bf4(pr + P_PAD) : z;
    const f32x4 m0 = *(const f32x4*)(mu + col), m1 = *(const f32x4*)(mu + P_RWKV + col);
    return c + m0 * (pv - c) + m1 * (nx - c);
}
__device__ __forceinline__ void st_bf4(bf16_t* p, f32x4 v) { u32x2 w; w.x = pg8::cvt_pk_bf16(v.x, v.y); w.y = pg8::cvt_pk_bf16(v.z, v.w); *(u32x2*)p = w; }
__device__ __forceinline__ f32x4 sig4(f32x4 x) { return (f32x4){sigmoidf_(x.x), sigmoidf_(x.y), sigmoidf_(x.z), sigmoidf_(x.w)}; }
__device__ __forceinline__ void st_bf8(bf16_t* p, f32x4 a, f32x4 b) { u32x4 w; w.x = pg8::cvt_pk_bf16(a.x, a.y); w.y = pg8::cvt_pk_bf16(a.z, a.w); w.z = pg8::cvt_pk_bf16(b.x, b.y); w.w = pg8::cvt_pk_bf16(b.z, b.w); *(u32x4*)p = w; }
__device__ __forceinline__ void qshift16(const bf16_t* P, int gr, bool hp, bool hn, int col, const LAS float* mu0, const LAS float* mu1, f32x4 (&o)[4]) {
    const bf16_t* pr = P + (size_t)gr * P_PAD + Q0 + col;
    f32x4 c[4], pv[4], nx[4]; const f32x4 z = (f32x4){0.f, 0.f, 0.f, 0.f};
    ld_bf8(pr, c[0], c[1]); ld_bf8(pr + 8, c[2], c[3]);
    if (hp) { ld_bf8(pr - P_PAD, pv[0], pv[1]); ld_bf8(pr - P_PAD + 8, pv[2], pv[3]); } else { pv[0] = z; pv[1] = z; pv[2] = z; pv[3] = z; }
    if (hn) { ld_bf8(pr + P_PAD, nx[0], nx[1]); ld_bf8(pr + P_PAD + 8, nx[2], nx[3]); } else { nx[0] = z; nx[1] = z; nx[2] = z; nx[3] = z; }
#pragma unroll
    for (int n = 0; n < 4; ++n) o[n] = c[n] + *(const LAS f32x4*)(mu0 + 4 * n) * (pv[n] - c[n]) + *(const LAS f32x4*)(mu1 + 4 * n) * (nx[n] - c[n]);
}
__device__ __forceinline__ void p3_inputs(Frame& F) {
    LAS bf16_t* low = (LAS bf16_t*)F.lds;
    LAS float* par = (LAS float*)(F.lds + 16384) + F.wave * (2 * 12 * 64);
    const bf16_t* P = WSP(bf16_t, WS_P); const float* mu = IN_MU; const bf16_t* WT = WSP(bf16_t, WS_WT);
    bf16_t* Ub = WSP(bf16_t, WS_SC); bf16_t* SBb = WSP(bf16_t, WS_SB); bf16_t* G = WSP(bf16_t, WS_G);
    const int tok = F.lane & 15, q = F.lane >> 4;
#pragma unroll
    for (int hh = 0; hh < 2; ++hh) { const int ch = (2 * F.wave + hh) * 64 + F.lane; LAS float* pp = par + hh * 12 * 64 + F.lane;
        pp[0 * 64] = IN_KK[ch]; pp[1 * 64] = IN_KA[ch]; pp[2 * 64] = IN_W0[ch]; pp[3 * 64] = IN_W0[DR + ch]; pp[4 * 64] = IN_A0[ch]; pp[5 * 64] = IN_A0[DR + ch];
        pp[6 * 64] = mu[ch]; pp[7 * 64] = mu[P_RWKV + ch]; pp[8 * 64] = mu[1024 + ch]; pp[9 * 64] = mu[P_RWKV + 1024 + ch]; pp[10 * 64] = mu[2304 + ch]; pp[11 * 64] = mu[P_RWKV + 2304 + ch]; }
    for (int tile = F.bx; tile < M_ALL / 16; tile += F.G) {
        const int row0 = tile * 16; int s0, s1;
        if (row0 < M_LAT) { s0 = (row0 / T) * T; s1 = s0 + T; } else { s0 = M_LAT + ((row0 - M_LAT) / TC) * TC; s1 = s0 + TC; }
        const bool lat = row0 < M_LAT;
        __syncthreads();
        for (int i = F.tid; i < 16 * (LOWW / 4); i += NTHR) { const int tk = i / (LOWW / 4), c4 = (i % (LOWW / 4)) * 4, col = c4 < 256 ? 2048 + c4 : 3328 + (c4 - 256);
            f32x4 qv = qshift4(P, mu, row0 + tk, row0 + tk > s0, row0 + tk + 1 < s1, col);
            if (c4 < 128) qv = (f32x4){1.0f - 2.0f * __builtin_amdgcn_rcpf(1.0f + __expf(2.0f * qv.x)), 1.0f - 2.0f * __builtin_amdgcn_rcpf(1.0f + __expf(2.0f * qv.y)), 1.0f - 2.0f * __builtin_amdgcn_rcpf(1.0f + __expf(2.0f * qv.z)), 1.0f - 2.0f * __builtin_amdgcn_rcpf(1.0f + __expf(2.0f * qv.w))};
            else if (c4 >= 256) qv = sig4(qv);
            u32x2 w; w.x = pg8::cvt_pk_bf16(qv.x, qv.y); w.y = pg8::cvt_pk_bf16(qv.z, qv.w); *(LAS u32x2*)(low + tk * LOWP + c4) = w; }
        __syncthreads();
        bf16x8 af[13];
#pragma unroll
        for (int s = 0; s < 13; ++s) af[s] = *(const LAS bf16x8*)(low + tok * LOWP + 32 * s + 8 * q);
        const int gr = row0 + tok; const bool hp = gr > s0, hn = gr + 1 < s1;
#pragma unroll 1
        for (int hh = 0; hh < 2; ++hh) {
            const int head = 2 * F.wave + hh; const int cb = head * 64 + 16 * q;
            const LAS float* pl = par + hh * 12 * 64 + 16 * q;
            f32x4 acc[4][5];
#pragma unroll
            for (int n = 0; n < 4; ++n) {
                const bf16_t* wrow = WT + (size_t)(head * 64 + 16 * (tok >> 2) + 4 * n + (tok & 3)) * LOWW + 8 * q;
#pragma unroll
                for (int x = 0; x < 5; ++x) acc[n][x] = (f32x4){0.f, 0.f, 0.f, 0.f};
#pragma unroll
                for (int s = 0; s < 13; ++s) { const bf16x8 bw = *(const bf16x8*)(wrow + 32 * s); const int x = s < 8 ? (s >> 1) : 4;
                    acc[n][x] = __builtin_amdgcn_mfma_f32_16x16x32_bf16(bw, af[s], acc[n][x], 0, 0, 0); }
            }
            const size_t o = (size_t)gr * DR + cb;
            f32x4 k[4]; qshift16(P, gr, hp, hn, cb, pl + 6 * 64, pl + 7 * 64, k);
            f32x4 kr[4]; float ss = 0.f;
#pragma unroll
            for (int n = 0; n < 4; ++n) { kr[n] = k[n] * *(const LAS f32x4*)(pl + 0 * 64 + 4 * n); ss += (kr[n].x * kr[n].x + kr[n].y * kr[n].y) + (kr[n].z * kr[n].z + kr[n].w * kr[n].w); }
            ss += __shfl_xor(ss, 16); ss += __shfl_xor(ss, 32);
            const float rn = 1.0f / sqrtf(fmaxf(ss, KK_EPS));
#pragma unroll
            for (int n = 0; n < 4; ++n) kr[n] = kr[n] * rn;
            st_bf8(SBb + (size_t)SB_NKK * (SB_STRIDE / 2) + o, -kr[0], -kr[1]); st_bf8(SBb + (size_t)SB_NKK * (SB_STRIDE / 2) + o + 8, -kr[2], -kr[3]);
#pragma unroll
            for (int d = 0; d < 2; ++d) {
                f32x4 uu[4], kd[4], bb[4];
#pragma unroll
                for (int n = 0; n < 4; ++n) {
                    uu[n] = sig4(acc[n][d] + *(const LAS f32x4*)(pl + (2 + d) * 64 + 4 * n)) * 0.60653066f;
                    const f32x4 a = sig4(acc[n][2 + d] + *(const LAS f32x4*)(pl + (4 + d) * 64 + 4 * n));
                    kd[n] = k[n] * ((a - 1.0f) * *(const LAS f32x4*)(pl + 1 * 64 + 4 * n) + 1.0f); bb[n] = kr[n] * a; }
                st_bf8(Ub + (size_t)d * (SC_STRIDE / 2) + o, uu[0], uu[1]); st_bf8(Ub + (size_t)d * (SC_STRIDE / 2) + o + 8, uu[2], uu[3]);
                st_bf8(SBb + (size_t)(SB_KD + d) * (SB_STRIDE / 2) + o, kd[0], kd[1]); st_bf8(SBb + (size_t)(SB_KD + d) * (SB_STRIDE / 2) + o + 8, kd[2], kd[3]);
                st_bf8(SBb + (size_t)(SB_BB + d) * (SB_STRIDE / 2) + o, bb[0], bb[1]); st_bf8(SBb + (size_t)(SB_BB + d) * (SB_STRIDE / 2) + o + 8, bb[2], bb[3]);
            }
            if (lat) { st_bf8(G + o, acc[0][4], acc[1][4]); st_bf8(G + o + 8, acc[2][4], acc[3][4]); }
            { f32x4 v[4]; qshift16(P, gr, hp, hn, 1024 + cb, pl + 8 * 64, pl + 9 * 64, v);
              st_bf8(SBb + (size_t)SB_V * (SB_STRIDE / 2) + o, v[0], v[1]); st_bf8(SBb + (size_t)SB_V * (SB_STRIDE / 2) + o + 8, v[2], v[3]); }
            { f32x4 r[4]; qshift16(P, gr, hp, hn, 2304 + cb, pl + 10 * 64, pl + 11 * 64, r);
              st_bf8(SBb + (size_t)SB_R * (SB_STRIDE / 2) + o, r[0], r[1]); st_bf8(SBb + (size_t)SB_R * (SB_STRIDE / 2) + o + 8, r[2], r[3]); }
        }
    }
    __syncthreads();
}

__device__ __forceinline__ float fma_(float a, float b, float c) { float d; asm("v_fma_f32 %0, %1, %2, %3" : "=v"(d) : "v"(a), "v"(b), "v"(c)); return d; }
__device__ __forceinline__ float mul_(float a, float b) { float d; asm("v_mul_f32 %0, %1, %2" : "=v"(d) : "v"(a), "v"(b)); return d; }
__device__ __forceinline__ float add_(float a, float b) { float d; asm("v_add_f32 %0, %1, %2" : "=v"(d) : "v"(a), "v"(b)); return d; }
template <int OFF> __device__ __forceinline__ f32x4 lds_rd128(unsigned addr) { f32x4 v; asm volatile("ds_read_b128 %0, %1 offset:%2" : "=&v"(v) : "v"(addr), "n"(OFF)); return v; }
template <int OFF> __device__ __forceinline__ float lds_rd32(unsigned addr) { float v; asm volatile("ds_read_b32 %0, %1 offset:%2" : "=&v"(v) : "v"(addr), "n"(OFF)); return v; }
__device__ __forceinline__ f32x2 pk_mul(f32x2 a, f32x2 b) { f32x2 d; asm("v_pk_mul_f32 %0, %1, %2" : "=v"(d) : "v"(a), "v"(b)); return d; }
__device__ __forceinline__ f32x2 pk_fma(f32x2 a, f32x2 b, f32x2 c) { f32x2 d; asm("v_pk_fma_f32 %0, %1, %2, %3" : "=v"(d) : "v"(a), "v"(b), "v"(c)); return d; }
__device__ __forceinline__ f32x2 pk_mul_b0(f32x2 a, f32x2 b) { f32x2 d; asm("v_pk_mul_f32 %0, %1, %2 op_sel_hi:[0,1]" : "=v"(d) : "v"(a), "v"(b)); return d; }
__device__ __forceinline__ f32x2 pk_fma_b0(f32x2 a, f32x2 b, f32x2 c) { f32x2 d; asm("v_pk_fma_f32 %0, %1, %2, %3 op_sel_hi:[0,1,1]" : "=v"(d) : "v"(a), "v"(b), "v"(c)); return d; }
#define LO2(v4) __builtin_shufflevector(v4, v4, 0, 1)
#define HI2(v4) __builtin_shufflevector(v4, v4, 2, 3)
template <int CTRL> __device__ __forceinline__ float dpp_add(float x) { return x + __builtin_bit_cast(float, __builtin_amdgcn_update_dpp(0, __builtin_bit_cast(int, x), CTRL, 0xF, 0xF, true)); }
__device__ __forceinline__ float row16_sum(float x) { x = dpp_add<0xB1>(x); x = dpp_add<0x4E>(x); x = dpp_add<0x124>(x); x = dpp_add<0x128>(x); return x; }
__device__ __forceinline__ int scan_row(int step, int b, int d) {
    if (step < TC) { const int t = d ? TC - 1 - step : step; return M_LAT + b * TC + t; }
    int t = step - TC; t = d ? T - 1 - t : t; return b * T + t;
}
struct CvItem { const float* src; unsigned char* dst; int N; };
constexpr int CV_GU1 = (D / 128) * (2 * DE / 32), CV_DN1 = (DE / 128) * (D / 32), CV_ITEMS = NE * (CV_GU1 + CV_DN1);
__device__ __forceinline__ CvItem cv_decode(Frame& F, int it) {
    const float* W; unsigned char* WT; int N, row_off, r;
    if (it < NE * CV_GU1) { const int e = it / CV_GU1; r = it - e * CV_GU1; W = IN_WGU + (size_t)e * D * 2 * DE; WT = WSP(unsigned char, WS_WGU); N = 2 * DE; row_off = e * 2 * DE; }
    else { it -= NE * CV_GU1; const int e = it / CV_DN1; r = it - e * CV_DN1; W = IN_WDN + (size_t)e * DE * D; WT = WSP(unsigned char, WS_WDN); N = D; row_off = e * D; }
    const int nblk = N / 32, kb = r / nblk, nb = r % nblk;
    CvItem t; t.src = W + (size_t)(128 * kb) * N + 32 * nb; t.dst = WT + (size_t)(row_off + 32 * nb) * D + 128 * kb; t.N = N; return t;
}
#define CV_LOAD(v, t, lane_) do { const float* _s = (t).src + (size_t)(16 * ((lane_) >> 3)) * (t).N + 4 * ((lane_) & 7); \
    _Pragma("unroll") for (int i = 0; i < 16; ++i) v[i] = *(const f32x4*)(_s + (size_t)i * (t).N); } while (0)
__device__ __forceinline__ void cv_store(const f32x4 (&v)[16], const CvItem& t, LAS unsigned char* tile, int lane) {
    const int c = lane & 7, kg = lane >> 3;
#pragma unroll
    for (int j = 0; j < 4; ++j) { u32x4 w;
        w.x = pg8::pk4_fp8(v[0][j] * WSCALE, v[1][j] * WSCALE, v[2][j] * WSCALE, v[3][j] * WSCALE); w.y = pg8::pk4_fp8(v[4][j] * WSCALE, v[5][j] * WSCALE, v[6][j] * WSCALE, v[7][j] * WSCALE);
        w.z = pg8::pk4_fp8(v[8][j] * WSCALE, v[9][j] * WSCALE, v[10][j] * WSCALE, v[11][j] * WSCALE); w.w = pg8::pk4_fp8(v[12][j] * WSCALE, v[13][j] * WSCALE, v[14][j] * WSCALE, v[15][j] * WSCALE);
        *(LAS u32x4*)(tile + (4 * c + j) * 128 + ((kg ^ c) << 4)) = w; }
    LDS_WAIT(); asm volatile("" ::: "memory");
#pragma unroll
    for (int jj = 0; jj < 4; ++jj) { const int n = kg + 8 * jj;
        *(u32x4*)(t.dst + (size_t)n * D + 16 * c) = *(const LAS u32x4*)(tile + n * 128 + ((c ^ ((n >> 2) & 7)) << 4)); }
    LDS_WAIT(); asm volatile("" ::: "memory");
}
constexpr int SB = 32, SLOT_BYTES = 5 * SB * 256 + SB * 128, YB_OFF = 2 * SLOT_BYTES, YB_BYTES = SB * 128;
__device__ __forceinline__ float row8_sum(float x) { x = dpp_add<0xB1>(x); x = dpp_add<0x4E>(x); x = dpp_add<0x141>(x); return x; }
__device__ __forceinline__ void p4_scan(Frame& F) {
    bf16_t* Y = WSP(bf16_t, WS_Y);
    constexpr int NBLK = (TC + T) / SB;
    for (int task = F.bx; task < NB * NH * 2 * 2; task += F.G) {
        const int hf = (task >> 3) & 1, id_ = ((task >> 4) << 3) | (task & 7), d = id_ & 1, h = (id_ >> 1) & 15, b = id_ >> 5;
        __syncthreads();
        if (F.wave >= 4) {
            const int lt = F.tid - 256, lstep = lt >> 3, lpc = lt & 7;
            const bf16_t* Up = WSP(bf16_t, WS_SC) + (size_t)d * (SC_STRIDE / 2); const bf16_t* SBb = WSP(bf16_t, WS_SB);
            const bf16_t* arr[4] = { SBb + (size_t)SB_NKK * (SB_STRIDE / 2), SBb + (size_t)(SB_BB + d) * (SB_STRIDE / 2), SBb + (size_t)(SB_KD + d) * (SB_STRIDE / 2), SBb + (size_t)SB_R * (SB_STRIDE / 2) };
            const bf16_t* Vp = SBb + (size_t)SB_V * (SB_STRIDE / 2);
            struct Stage { u32x4 w; u32x4 o[4]; u32x4 v; };
            Stage sy;
#define P4_ISSUE(st, blk) do { const size_t ro = (size_t)scan_row((blk) * SB + lstep, b, d) * DR + h * 64; \
                st.w = *(const u32x4*)(Up + ro + lpc * 8); \
                _Pragma("unroll") for (int a = 0; a < 4; ++a) st.o[a] = *(const u32x4*)(arr[a] + ro + lpc * 8); \
                if (lpc < 4) st.v = *(const u32x4*)(Vp + ro + hf * 32 + lpc * 8); } while (0)
#define P4_CVTLO(u) ((f32x4){__builtin_bit_cast(float, (u).x << 16), __builtin_bit_cast(float, (u).x & 0xffff0000u), __builtin_bit_cast(float, (u).y << 16), __builtin_bit_cast(float, (u).y & 0xffff0000u)})
#define P4_CVTHI(u) ((f32x4){__builtin_bit_cast(float, (u).z << 16), __builtin_bit_cast(float, (u).z & 0xffff0000u), __builtin_bit_cast(float, (u).w << 16), __builtin_bit_cast(float, (u).w & 0xffff0000u)})
#define P4_COMMIT(st, slot) do { LAS unsigned char* sb_ = F.lds + (slot) * SLOT_BYTES + lstep * 256 + lpc * 32; \
                { const f32x4 u0_ = P4_CVTLO(st.w), u1_ = P4_CVTHI(st.w); *(LAS f32x4*)(sb_) = (f32x4){__expf(-u0_.x), __expf(-u0_.y), __expf(-u0_.z), __expf(-u0_.w)}; *(LAS f32x4*)(sb_ + 16) = (f32x4){__expf(-u1_.x), __expf(-u1_.y), __expf(-u1_.z), __expf(-u1_.w)}; } \
                _Pragma("unroll") for (int a = 0; a < 4; ++a) { *(LAS f32x4*)(sb_ + (a + 1) * (SB * 256)) = P4_CVTLO(st.o[a]); *(LAS f32x4*)(sb_ + (a + 1) * (SB * 256) + 16) = P4_CVTHI(st.o[a]); } \
                if (lpc < 4) { LAS unsigned char* vb_ = F.lds + (slot) * SLOT_BYTES + 5 * (SB * 256) + lstep * 128 + lpc * 32; *(LAS f32x4*)(vb_) = P4_CVTLO(st.v); *(LAS f32x4*)(vb_ + 16) = P4_CVTHI(st.v); } } while (0)
            P4_ISSUE(sy, 0); P4_COMMIT(sy, 0);
            P4_ISSUE(sy, 1);
            LAS unsigned char* cvtile = F.lds + YB_OFF + 2 * YB_BYTES + (F.wave - 4) * 4096;
            const int cvstride = F.G * 4; int cvit = (task == F.bx) ? F.bx * 4 + (F.wave - 4) : CV_ITEMS;
            f32x4 cvv[16]; CvItem cvt = cv_decode(F, cvit < CV_ITEMS ? cvit : 0); bool cvhave = cvit < CV_ITEMS;
            if (cvhave) CV_LOAD(cvv, cvt, F.lane);
            asm volatile("s_waitcnt lgkmcnt(0)" ::: "memory"); __builtin_amdgcn_s_barrier(); asm volatile("" ::: "memory");
            for (int blk = 0; blk < NBLK; ++blk) {
                if (blk + 1 < NBLK) P4_COMMIT(sy, (blk + 1) & 1);
                if (blk + 2 < NBLK) P4_ISSUE(sy, blk + 2);
                if (blk > 0 && (blk - 1) * SB >= TC) {
                    const LAS float* yb = (const LAS float*)(F.lds + YB_OFF + ((blk - 1) & 1) * YB_BYTES);
                    const int row = scan_row((blk - 1) * SB + lstep, b, d);
                    st_bf4(Y + (size_t)d * M_LAT * DR + (size_t)row * DR + h * 64 + hf * 32 + lpc * 4, *(const LAS f32x4*)(yb + lstep * 32 + lpc * 4));
                }
                if (cvhave) { cv_store(cvv, cvt, cvtile, F.lane); cvit += cvstride; cvhave = cvit < CV_ITEMS; if (cvhave) { cvt = cv_decode(F, cvit); CV_LOAD(cvv, cvt, F.lane); } }
                asm volatile("s_waitcnt lgkmcnt(0)" ::: "memory"); __builtin_amdgcn_s_barrier(); asm volatile("" ::: "memory");
            }
            while (cvhave) { cv_store(cvv, cvt, cvtile, F.lane); cvit += cvstride; cvhave = cvit < CV_ITEMS; if (cvhave) { cvt = cv_decode(F, cvit); CV_LOAD(cvv, cvt, F.lane); } }
            {   const LAS float* yb = (const LAS float*)(F.lds + YB_OFF + ((NBLK - 1) & 1) * YB_BYTES);
                const int row = scan_row((NBLK - 1) * SB + lstep, b, d);
                st_bf4(Y + (size_t)d * M_LAT * DR + (size_t)row * DR + h * 64 + hf * 32 + lpc * 4, *(const LAS f32x4*)(yb + lstep * 32 + lpc * 4)); }
#undef P4_ISSUE
#undef P4_COMMIT
#undef P4_CVTLO
#undef P4_CVTHI
        } else {
            const int rho = F.lane >> 3, kap = F.lane & 7, rloc = 8 * F.wave + rho;
            f32x2 s0 = {0.f, 0.f}, s1 = {0.f, 0.f}, s2 = {0.f, 0.f}, s3 = {0.f, 0.f};
            asm volatile("s_waitcnt lgkmcnt(0)" ::: "memory"); __builtin_amdgcn_s_barrier(); asm volatile("" ::: "memory");
            for (int blk = 0; blk < NBLK; ++blk) {
                const LAS unsigned char* sb = F.lds + (blk & 1) * SLOT_BYTES;
                LAS float* yb = (LAS float*)(F.lds + YB_OFF + (blk & 1) * YB_BYTES);
                const unsigned aK = (unsigned)(size_t)(sb) + kap * 32, aV = (unsigned)(size_t)(sb) + 5 * (SB * 256) + rloc * 4;
                f32x4 cw0, cw1, ca0, ca1, cb0, cb1, ck0, ck1, cr0, cr1; float cv;
#define P4_RDSET(P, base_, boff_, vbase_, voff_) do { P##w0 = lds_rd128<(boff_)>(base_); P##w1 = lds_rd128<(boff_) + 16>(base_); P##a0 = lds_rd128<(boff_) + SB * 256>(base_); P##a1 = lds_rd128<(boff_) + SB * 256 + 16>(base_); \
                    P##b0 = lds_rd128<(boff_) + 2 * SB * 256>(base_); P##b1 = lds_rd128<(boff_) + 2 * SB * 256 + 16>(base_); P##k0 = lds_rd128<(boff_) + 3 * SB * 256>(base_); P##k1 = lds_rd128<(boff_) + 3 * SB * 256 + 16>(base_); \
                    P##r0 = lds_rd128<(boff_) + 4 * SB * 256>(base_); P##r1 = lds_rd128<(boff_) + 4 * SB * 256 + 16>(base_); P##v = lds_rd32<(voff_)>(vbase_); } while (0)
#define P4_TIE(P) "+v"(P##w0), "+v"(P##w1), "+v"(P##a0), "+v"(P##a1), "+v"(P##b0), "+v"(P##b1), "+v"(P##k0), "+v"(P##k1), "+v"(P##r0), "+v"(P##r1), "+v"(P##v)
                P4_RDSET(c, aK, 0, aV, 0);
                asm volatile("s_waitcnt lgkmcnt(0)" : P4_TIE(c));
#pragma unroll 1
                for (int i0 = 0; i0 < SB; i0 += 8) {
                    float ykeep = 0.f; const unsigned aK0 = aK + i0 * 256, aV0 = aV + i0 * 128;
#define P4_STEP(II) do { f32x4 nw0, nw1, na0, na1, nb0, nb1, nk0, nk1, nr0, nr1; float nv; \
                        asm volatile("" : "+v"(s0)); \
                        P4_RDSET(n, aK0, ((II) + 1) * 256, aV0, ((II) + 1) * 128); \
                        f32x2 pp = pk_mul(s0, LO2(ca0)); pp = pk_fma(s1, HI2(ca0), pp); pp = pk_fma(s2, LO2(ca1), pp); pp = pk_fma(s3, HI2(ca1), pp); \
                        f32x2 cvp; cvp.x = cv; const f32x2 t0 = pk_mul_b0(cvp, LO2(ck0)), t1 = pk_mul_b0(cvp, HI2(ck0)), t2 = pk_mul_b0(cvp, LO2(ck1)), t3 = pk_mul_b0(cvp, HI2(ck1)); \
                        f32x2 sap; sap.x = row8_sum(add_(pp.x, pp.y)); \
                        s0 = pk_fma(s0, LO2(cw0), pk_fma_b0(sap, LO2(cb0), t0)); s1 = pk_fma(s1, HI2(cw0), pk_fma_b0(sap, HI2(cb0), t1)); \
                        s2 = pk_fma(s2, LO2(cw1), pk_fma_b0(sap, LO2(cb1), t2)); s3 = pk_fma(s3, HI2(cw1), pk_fma_b0(sap, HI2(cb1), t3)); \
                        f32x2 qq = pk_mul(s0, LO2(cr0)); qq = pk_fma(s1, HI2(cr0), qq); qq = pk_fma(s2, LO2(cr1), qq); qq = pk_fma(s3, HI2(cr1), qq); \
                        const float y = row8_sum(add_(qq.x, qq.y)); \
                        ykeep = (kap == (II)) ? y : ykeep; \
                        asm volatile("s_waitcnt lgkmcnt(0)" : P4_TIE(n), "+v"(s0)); \
                        cw0 = nw0; cw1 = nw1; ca0 = na0; ca1 = na1; cb0 = nb0; cb1 = nb1; ck0 = nk0; ck1 = nk1; cr0 = nr0; cr1 = nr1; cv = nv; } while (0)
                    P4_STEP(0); P4_STEP(1); P4_STEP(2); P4_STEP(3); P4_STEP(4); P4_STEP(5); P4_STEP(6); P4_STEP(7);
#undef P4_STEP
                    yb[(i0 + kap) * 32 + rloc] = ykeep;
                }
#undef P4_RDSET
#undef P4_TIE
                asm volatile("s_waitcnt lgkmcnt(0)" ::: "memory"); __builtin_amdgcn_s_barrier(); asm volatile("" ::: "memory");
            }
        }
        __syncthreads();
    }
}

__device__ __forceinline__ f32x4 row16_sum4(f32x4 v) { return (f32x4){row16_sum(v.x), row16_sum(v.y), row16_sum(v.z), row16_sum(v.w)}; }
__device__ __forceinline__ void p5_readout(Frame& F) {
    const bf16_t* SBb = WSP(bf16_t, WS_SB); const bf16_t* Y = WSP(bf16_t, WS_Y); const bf16_t* G = WSP(bf16_t, WS_G);
    const bf16_t* P = WSP(bf16_t, WS_P); bf16_t* MI = WSP(bf16_t, WS_MIXIN);
    const int t4 = F.lane >> 4, q = F.lane & 15;
    f32x4 rk[2], lw[2], lb[2];
#pragma unroll
    for (int hh = 0; hh < 2; ++hh) { const int c = (F.wave + 8 * hh) * 64 + 4 * q; rk[hh] = *(const f32x4*)(IN_RK + c); lw[hh] = *(const f32x4*)(IN_LNXW + c); lb[hh] = *(const f32x4*)(IN_LNXB + c); }
    const int cc = 128 * F.wave + 8 * q;
    f32x4 cw[3][2];
#pragma unroll
    for (int k = 0; k < 3; ++k) { cw[k][0] = *(const f32x4*)(IN_CONVW + k * DC + cc); cw[k][1] = *(const f32x4*)(IN_CONVW + k * DC + cc + 4); }
    for (int tg = F.bx; tg < M_LAT / 4; tg += F.G) {
        const int tok = 4 * tg + t4;
#pragma unroll
        for (int hh = 0; hh < 2; ++hh) {
            const int c = (F.wave + 8 * hh) * 64 + 4 * q; const size_t o = (size_t)tok * DR + c;
            const f32x4 r = ld_bf4(SBb + (size_t)SB_R * (SB_STRIDE / 2) + o), v = ld_bf4(SBb + (size_t)SB_V * (SB_STRIDE / 2) + o), g = ld_bf4(G + o);
            f32x4 osum = (f32x4){0.f, 0.f, 0.f, 0.f};
#pragma unroll
            for (int d = 0; d < 2; ++d) {
                const f32x4 y = ld_bf4(Y + (size_t)d * M_LAT * DR + o), kd = ld_bf4(SBb + (size_t)(SB_KD + d) * (SB_STRIDE / 2) + o);
                const float mu = row16_sum((y.x + y.y) + (y.z + y.w)) * (1.0f / 64.0f); const f32x4 dy = y - mu;
                const float var = row16_sum((dy.x * dy.x + dy.y * dy.y) + (dy.z * dy.z + dy.w * dy.w)) * (1.0f / 64.0f);
                const f32x4 rr = r * kd * rk[hh]; const float bonus = row16_sum((rr.x + rr.y) + (rr.z + rr.w));
                osum += dy * (1.0f / sqrtf(var + LNX_EPS)) * lw[hh] + lb[hh] + bonus * v;
            }
            st_bf4(MI + (size_t)tok * D + DC + c, osum * g);
        }
        {
            const int col = tok & 63; const bf16_t* pr = P + (size_t)tok * P_PAD + cc;
            f32x4 gb0, gb1, gc0, gc1, u0, u1, pg0, pg1, pu0, pu1, ng0, ng1, nu0, nu1; const f32x4 z = (f32x4){0.f, 0.f, 0.f, 0.f};
            ld_bf8(pr, gb0, gb1); ld_bf8(pr + DC, gc0, gc1); ld_bf8(pr + 2 * DC, u0, u1);
            if (col > 0) { ld_bf8(pr - P_PAD + DC, pg0, pg1); ld_bf8(pr - P_PAD + 2 * DC, pu0, pu1); } else { pg0 = z; pg1 = z; pu0 = z; pu1 = z; }
            if (col < 63) { ld_bf8(pr + P_PAD + DC, ng0, ng1); ld_bf8(pr + P_PAD + 2 * DC, nu0, nu1); } else { ng0 = z; ng1 = z; nu0 = z; nu1 = z; }
            const f32x4 o0 = gb0 * ((pg0 * pu0) * cw[0][0] + (gc0 * u0) * cw[1][0] + (ng0 * nu0) * cw[2][0]);
            const f32x4 o1 = gb1 * ((pg1 * pu1) * cw[0][1] + (gc1 * u1) * cw[1][1] + (ng1 * nu1) * cw[2][1]);
            u32x4 w; w.x = pg8::cvt_pk_bf16(o0.x, o0.y); w.y = pg8::cvt_pk_bf16(o0.z, o0.w); w.z = pg8::cvt_pk_bf16(o1.x, o1.y); w.w = pg8::cvt_pk_bf16(o1.z, o1.w);
            *(u32x4*)(MI + (size_t)tok * D + cc) = w;
        }
    }
}

__device__ __forceinline__ void p7_route(Frame& F, const bool do_route) {
    const float* mod = WSP(float, WS_MOD); const bf16_t* MIX = WSP(bf16_t, WS_MIX); bf16_t* X1 = WSP(bf16_t, WS_X1); unsigned char* H2 = WSP(unsigned char, WS_H2);
    int* tok_e = WSP(int, WS_ROUTE); int* tok_rank = tok_e + M_LAT * TOPK; float* tok_gate = (float*)(tok_rank + M_LAT * TOPK); int* elist = (int*)(tok_gate + M_LAT * TOPK);
    unsigned* cnt = WSP(unsigned, WS_CTL) + CW_CNT;
    const int gw = F.bx * NWAVES + F.wave, NGW = F.G * NWAVES, rep = F.bx % RR;
    LAS unsigned* lcnt = (LAS unsigned*)F.lds;
    LAS float* hbuf = (LAS float*)(F.lds + 1024);
    LAS float* part = (LAS float*)(F.lds + 1024 + 65536);
    LAS float* lgb = (LAS float*)(F.lds + 1024 + 65536 + 16384);
    __syncthreads();
    if (F.tid < 64) lcnt[F.tid] = 0u;
    __syncthreads();
    const int re = F.tid & 31, kp = F.tid >> 5;
    for (int row_ = gw; row_ < M_LAT + gw; row_ += NGW) {
        if (row_ - gw >= ((M_LAT + NGW - 1) / NGW) * NGW) break;
        const bool valid = row_ < M_LAT; const int row = valid ? row_ : M_LAT - 1;
        const float* mr = mod + (row / T) * NMOD;
        f32x4 v[8]; float ss = 0.f;
#pragma unroll
        for (int j = 0; j < 8; ++j) { v[j] = ld_bf4(MIX + (size_t)row * D + 4 * F.lane + 256 * j); ss += (v[j].x * v[j].x + v[j].y * v[j].y) + (v[j].z * v[j].z + v[j].w * v[j].w); }
        float rstd = 1.0f / sqrtf(wave_sum(ss) * (1.0f / D) + RMS_EPS);
        ss = 0.f;
#pragma unroll
        for (int j = 0; j < 8; ++j) { const int c = 4 * F.lane + 256 * j;
            const f32x4 xv = *(const f32x4*)(IN_X + (size_t)row * D + c), g = *(const f32x4*)(IN_NORMG + D + c), gt = *(const f32x4*)(mr + 2 * D + c);
            v[j] = xv + gt * (v[j] * rstd * g);
            if (valid) st_bf4(X1 + (size_t)row * D + c, v[j]);
            ss += (v[j].x * v[j].x + v[j].y * v[j].y) + (v[j].z * v[j].z + v[j].w * v[j].w); }
        rstd = 1.0f / sqrtf(wave_sum(ss) * (1.0f / D) + RMS_EPS);
#pragma unroll
        for (int j = 0; j < 8; ++j) { const int c = 4 * F.lane + 256 * j;
            const f32x4 g = *(const f32x4*)(IN_NORMG + 2 * D + c), sh = *(const f32x4*)(mr + 3 * D + c), sc = *(const f32x4*)(mr + 4 * D + c);
            const f32x4 hv = (v[j] * rstd * g) * (sc + 1.0f) + sh;
            if (valid) *(unsigned*)(H2 + (size_t)row * D + c) = pg8::pk4_fp8(hv.x, hv.y, hv.z, hv.w);
            *(LAS f32x4*)(hbuf + F.wave * D + c) = hv; }
        __syncthreads();
        {
            float acc[8];
#pragma unroll
            for (int r = 0; r < 8; ++r) acc[r] = 0.f;
            const float* wp = IN_WROUTER + (size_t)(128 * kp) * NE + re;
#pragma unroll 4
            for (int c4 = 0; c4 < 128; c4 += 4) {
                const float w0 = wp[(size_t)(c4 + 0) * NE], w1 = wp[(size_t)(c4 + 1) * NE], w2 = wp[(size_t)(c4 + 2) * NE], w3 = wp[(size_t)(c4 + 3) * NE];
#pragma unroll
                for (int r = 0; r < 8; ++r) { const f32x4 h = *(const LAS f32x4*)(hbuf + r * D + 128 * kp + c4); acc[r] += (h.x * w0 + h.y * w1) + (h.z * w2 + h.w * w3); } }
#pragma unroll
            for (int r = 0; r < 8; ++r) part[(kp * 8 + r) * 32 + re] = acc[r];
        }
        __syncthreads();
        if (F.tid < 256) { const int r = F.tid >> 5; float s = IN_BROUTER[re];
#pragma unroll
            for (int k2 = 0; k2 < 16; ++k2) s += part[(k2 * 8 + r) * 32 + re];
            lgb[r * 32 + re] = s; }
        __syncthreads();
        float lg[NE];
#pragma unroll
        for (int e4 = 0; e4 < NE / 4; ++e4) { const f32x4 t = *(const LAS f32x4*)(lgb + F.wave * 32 + 4 * e4); lg[4 * e4] = t.x; lg[4 * e4 + 1] = t.y; lg[4 * e4 + 2] = t.z; lg[4 * e4 + 3] = t.w; }
        unsigned taken = 0u; int es[TOPK]; float vs[TOPK];
#pragma unroll
        for (int k = 0; k < TOPK; ++k) { float best = -3.0e38f; int bi = 0;
#pragma unroll
            for (int e = 0; e < NE; ++e) { const bool ok = !((taken >> e) & 1u) && lg[e] > best; best = ok ? lg[e] : best; bi = ok ? e : bi; }
            taken |= 1u << bi; es[k] = bi; vs[k] = best; }
        float ps[TOPK], psum = 0.f;
#pragma unroll
        for (int k = 0; k < TOPK; ++k) { ps[k] = __expf(vs[k] - vs[0]); psum += ps[k]; }
        if (do_route && valid && F.lane < TOPK) {
            const int k = F.lane; const int e = k == 0 ? es[0] : k == 1 ? es[1] : k == 2 ? es[2] : es[3]; const float p = k == 0 ? ps[0] : k == 1 ? ps[1] : k == 2 ? ps[2] : ps[3];
            const int lr = (int)__hip_atomic_fetch_add(lcnt + e, 1u, __ATOMIC_RELAXED, __HIP_MEMORY_SCOPE_WORKGROUP);
            tok_e[row * TOPK + k] = e; tok_rank[row * TOPK + k] = lr; tok_gate[row * TOPK + k] = p / psum;
        }
    }
    if (!do_route) return;
    __syncthreads();
    if (F.tid < NE) { const unsigned c = lcnt[F.tid]; lcnt[32 + F.tid] = c ? atomicAdd(cnt + (rep * NE + F.tid) * 16, c) : 0u; }
    __syncthreads();
    for (int row = gw; row < M_LAT; row += NGW)
        if (F.lane < TOPK) { const int e = tok_e[row * TOPK + F.lane]; const int idx = (int)lcnt[32 + e] + tok_rank[row * TOPK + F.lane];
            tok_rank[row * TOPK + F.lane] = idx; elist[((size_t)e * RR + rep) * RCAP + idx] = row; }
}

__device__ __forceinline__ void p11_final(Frame& F) {
    build_tab(F);
    const LAS int* tab = (const LAS int*)(F.lds + TAB_OFF); const LAS int* rp = (const LAS int*)(F.lds + RP_OFF);
    const float* mod = WSP(float, WS_MOD); const bf16_t* X1 = WSP(bf16_t, WS_X1); const bf16_t* YM = WSP(bf16_t, WS_YM);
    const int* tok_e = WSP(int, WS_ROUTE); const int* tok_rank = tok_e + M_LAT * TOPK; const float* tok_gate = (const float*)(tok_rank + M_LAT * TOPK);
    const int gw = F.bx * NWAVES + F.wave, NGW = F.G * NWAVES;
    for (int row = gw; row < M_LAT; row += NGW) {
        const float* mr = mod + (row / T) * NMOD;
        f32x4 v[8];
#pragma unroll
        for (int j = 0; j < 8; ++j) v[j] = (f32x4){0.f, 0.f, 0.f, 0.f};
#pragma unroll
        for (int k = 0; k < TOPK; ++k) {
            const int e = tok_e[row * TOPK + k], rank = tok_rank[row * TOPK + k]; const float gt = tok_gate[row * TOPK + k];
            const bf16_t* yr = YM + (size_t)(tab[e] + rp[e * RR + ((row % NGW) / NWAVES) % RR] + rank) * D;
#pragma unroll
            for (int j = 0; j < 8; ++j) { const u32x2 w = *(const u32x2*)(yr + 4 * F.lane + 256 * j);
                v[j].x += gt * __builtin_bit_cast(float, w.x << 16); v[j].y += gt * __builtin_bit_cast(float, w.x & 0xffff0000u);
                v[j].z += gt * __builtin_bit_cast(float, w.y << 16); v[j].w += gt * __builtin_bit_cast(float, w.y & 0xffff0000u); }
        }
        float ss = 0.f;
#pragma unroll
        for (int j = 0; j < 8; ++j) ss += (v[j].x * v[j].x + v[j].y * v[j].y) + (v[j].z * v[j].z + v[j].w * v[j].w);
        const float rstd = 1.0f / sqrtf(wave_sum(ss) * (1.0f / D) + RMS_EPS);
#pragma unroll
        for (int j = 0; j < 8; ++j) { const int c = 4 * F.lane + 256 * j;
            const f32x4 xv = ld_bf4(X1 + (size_t)row * D + c), g = *(const f32x4*)(IN_NORMG + 3 * D + c), gt = *(const f32x4*)(mr + 5 * D + c);
            *(f32x4*)(F.out + (size_t)row * D + c) = xv + gt * (v[j] * rstd * g); }
    }
}

#ifndef MK_N_LAUNCHES
#define MK_N_LAUNCHES 1
#endif
constexpr int N_PHASES = 12;
struct Args { const float* in[27]; float* out; unsigned char* ws; int ph_lo, ph_hi; };
__global__ void __launch_bounds__(NTHR, 2) fwd_kernel(Args args) {
    extern __shared__ __attribute__((aligned(16))) unsigned char lds_raw[];
    Frame F;
    F.lds = (LAS unsigned char*)lds_raw;
    F.tid = threadIdx.x; F.lane = F.tid & 63; F.wave = __builtin_amdgcn_readfirstlane(F.tid >> 6);
    F.G = gridDim.x; F.bx = blockIdx.x;
#pragma unroll
    for (int i = 0; i < 27; ++i) F.in[i] = args.in[i];
    F.out = args.out; F.ws = args.ws;
    volatile LAS unsigned* MISC = (volatile LAS unsigned*)(F.lds + MISC_OFF);
    if (F.tid < 64) MISC[F.tid] = 0u;
    __syncthreads();
    XcdBarrier bar; bar.bar = WSP(unsigned, WS_CTL) + CW_BAR; bar.x = 0; bar.st = nullptr;
    if (MK_N_LAUNCHES == 1) bar = xcd_barrier_post(WSP(unsigned, WS_CTL) + CW_BAR, MISC + 8);
    const int lo = args.ph_lo, hi = args.ph_hi;
#define IN(k) (lo <= (k) && (k) < hi)
#define SEAM(k) do { if (IN(k) && IN((k) + 1)) xcd_barrier(bar); } while (0)

    if (IN(0)) { p0_prologue(F); SEAM(0); }
    if (IN(1)) { p1_norm(F); SEAM(1); }
    if (IN(2)) {
        const int n = build_list(F, 0);
        pg8::Gemm g{WSP(bf16_t, WS_H), WSP(bf16_t, WS_WIN), 2 * D}; pg8::ListOrder S{(const LAS int*)(F.lds + LIST_OFF), n};
        pg8::EpiBf16S E{WSP(bf16_t, WS_P), P_PAD, nullptr, 1 << 20, 0, 1.0f, F.lds + STG_OFF};
        pg8::gemm_phase<pg8::EpiBf16S, pg8::ListOrder, true, false>(F.lds, g, S, E);
        SEAM(2);
    }
    if (IN(3)) { p3_inputs(F); SEAM(3); }
    if (IN(4)) { p4_scan(F); SEAM(4); }
    if (IN(5)) { p5_readout(F); SEAM(5); }
    if (IN(6)) {
        const int n = build_list(F, 1);
        pg8::Gemm g{WSP(bf16_t, WS_MIXIN), WSP(bf16_t, WS_WOUT), 2 * D}; pg8::ListOrder S{(const LAS int*)(F.lds + LIST_OFF), n};
        pg8::EpiBf16S E{WSP(bf16_t, WS_MIX), D, nullptr, 1 << 20, 0, 1.0f, F.lds + STG_OFF};
        pg8::gemm_phase<pg8::EpiBf16S, pg8::ListOrder, true, false>(F.lds, g, S, E);
        SEAM(6);
    }
    if (IN(7)) { p7_route(F, true); if (IN(7) && IN(9)) xcd_barrier(bar); }
    if (IN(9)) {
        build_tab(F); const int n = build_list(F, 2);
        pg8::Gemm g{WSP(unsigned char, WS_H2), WSP(unsigned char, WS_WGU), D};
        const pg8::GatherInfo GI{WSP(int, WS_ROUTE) + 3 * M_LAT * TOPK, (const LAS int*)(F.lds + TAB_OFF), (const LAS int*)(F.lds + RP_OFF), 16, RR, RCAP}; pg8::ListOrder S{(const LAS int*)(F.lds + LIST_OFF), n};
        pg8::EpiSwigluS E{WSP(unsigned char, WS_ACT), DE, IN_BGU, 16, 2 * DE, 1.0f / WSCALE, F.lds + STG_OFF};
        pg8::gemm_phase<pg8::EpiSwigluS, pg8::ListOrder, true, true, true>(F.lds, g, S, E, GI);
        SEAM(9);
    }
    if (IN(10)) {
        build_tab(F); const int n = build_list(F, 3);
        pg8::Gemm g{WSP(unsigned char, WS_ACT), WSP(unsigned char, WS_WDN), DE}; pg8::ListOrder S{(const LAS int*)(F.lds + LIST_OFF), n};
        pg8::EpiBf16S E{WSP(bf16_t, WS_YM), D, IN_BDN, 8, D, 1.0f / WSCALE, F.lds + STG_OFF};
        pg8::gemm_phase<pg8::EpiBf16S, pg8::ListOrder, true, true>(F.lds, g, S, E);
        SEAM(10);
    }
    if (IN(11)) { p11_final(F); }
#undef IN
#undef SEAM
}

extern "C" void kernel_launch(void* const* d_in, const int* in_sizes, int n_in, void* d_out, int out_size, void* d_ws, size_t ws_size, hipStream_t stream) {
    static int grid = 0;
    if (grid == 0) {
        if (n_in != 27 || out_size != M_LAT * D || ws_size < WS_END) { fprintf(stderr, "kernel_launch: bad shapes (n_in %d, out %d, ws %zu < %zu); nothing launched\n", n_in, out_size, ws_size, (size_t)WS_END); grid = -1; return; }
        int dev = 0, cus = 0, per_cu = 0;
        if (hipGetDevice(&dev) != hipSuccess || hipDeviceGetAttribute(&cus, hipDeviceAttributeMultiprocessorCount, dev) != hipSuccess) { grid = -1; return; }
        if (hipFuncSetAttribute((const void*)fwd_kernel, hipFuncAttributeMaxDynamicSharedMemorySize, LDS_BYTES) != hipSuccess) { fprintf(stderr, "kernel_launch: hipFuncSetAttribute failed\n"); grid = -1; return; }
        if (hipOccupancyMaxActiveBlocksPerMultiprocessor(&per_cu, (const void*)fwd_kernel, NTHR, LDS_BYTES) != hipSuccess || per_cu < 1) fprintf(stderr, "kernel_launch: occupancy query reports %d\n", per_cu);
        (void)hipGetLastError();
        grid = cus;
    }
    if (grid < 0) return;
    if (hipMemsetAsync((char*)d_ws + WS_CTL, 0, CTL_ZERO_BYTES, stream) != hipSuccess) return;
    Args a{};
    for (int i = 0; i < 27; ++i) a.in[i] = (const float*)d_in[i];
    a.out = (float*)d_out; a.ws = (unsigned char*)d_ws;
    if (MK_N_LAUNCHES == 1) { a.ph_lo = 0; a.ph_hi = N_PHASES; hipLaunchKernelGGL(fwd_kernel, dim3(grid), dim3(NTHR), LDS_BYTES, stream, a); }
    if (MK_N_LAUNCHES != 1) for (int p = 0; p < N_PHASES; ++p) { a.ph_lo = p; a.ph_hi = p + 1; hipLaunchKernelGGL(fwd_kernel, dim3(grid), dim3(NTHR), LDS_BYTES, stream, a); }
}
```

```cpp
#include <hip/hip_runtime.h>
#include <cstdio>
#include <cstdint>

#define GAS __attribute__((address_space(1)))
#define LAS __attribute__((address_space(3)))
typedef unsigned short bf16_t;
typedef short bf16x8 __attribute__((ext_vector_type(8)));
typedef float f32x4 __attribute__((ext_vector_type(4)));
typedef float f32x2 __attribute__((ext_vector_type(2)));
typedef unsigned u32x4 __attribute__((ext_vector_type(4)));
typedef unsigned u32x2 __attribute__((ext_vector_type(2)));
typedef int i32x4 __attribute__((ext_vector_type(4)));
typedef int i32x8 __attribute__((ext_vector_type(8)));

namespace pg8 {
constexpr int BM = 256, BK = 64, HALF = 128, HTB = HALF * BK * 2, STAGE_BYTES = 8 * HTB, NXCD = 8, WGM = 8;
__host__ __device__ __forceinline__ int lds_byte(int r, int c) { const int st = (r >> 4) * 2 + (c >> 5), rr = r & 15, cc = c & 31, ob = rr * 64 + cc * 2; return st * 1024 + (ob ^ (((ob >> 9) & 1) << 5)); }
__host__ __device__ __forceinline__ void stage_rc(int b, int& R, int& C) { const int st = b / 1024, sb = b % 1024, swz = sb ^ (((sb >> 9) & 1) << 5); R = (st >> 1) * 16 + swz / 64; C = (st & 1) * 32 + (swz % 64) / 2; }
__host__ __device__ __forceinline__ int perm32(int rho) { const int n = rho >> 4, i = rho & 15; return 8 * (i >> 2) + 4 * n + (i & 3); }

struct Unit { int pm, pn; };
struct Gemm { const void* A; const void* Bt; int rowbytes; };

__device__ __forceinline__ unsigned cvt_pk_bf16(float lo, float hi) { unsigned r; asm volatile("v_cvt_pk_bf16_f32 %0, %1, %2" : "=v"(r) : "v"(lo), "v"(hi)); return r; }

struct ListOrder {
    const LAS int* list; int n;
    __device__ __forceinline__ bool next(int i, Unit& u) const { if (i >= n) return false; u.pm = list[2 * i]; u.pn = list[2 * i + 1]; return true; }
    __device__ __forceinline__ void a_ready(const Unit&) const {}
    __device__ __forceinline__ void done(const Unit&) const {}
};

struct EpiF32 {
    static constexpr bool PERM = false;
    float* C; int ldc;
    __device__ __forceinline__ void operator()(const f32x4 (&acc)[2][2][4][2], const Unit& u, int wr, int wc, int fr, int fq) const {
        const int row0 = u.pm * BM + wr * 64 + fr, col0 = u.pn * BM + wc * 32 + 4 * fq;
#pragma unroll
        for (int ai = 0; ai < 2; ++ai)
#pragma unroll
            for (int m = 0; m < 4; ++m) { float* rowp = C + (size_t)(row0 + ai * HALF + m * 16) * ldc + col0;
#pragma unroll
                for (int bj = 0; bj < 2; ++bj)
#pragma unroll
                    for (int n = 0; n < 2; ++n) *(f32x4*)(rowp + bj * HALF + n * 16) = acc[ai][bj][m][n]; }
    }
};
struct EpiBf16 {
    static constexpr bool PERM = true;
    bf16_t* O; int ldc; const float* bias; int npn; int bias_ld; float scale;
    __device__ __forceinline__ void operator()(const f32x4 (&acc)[2][2][4][2], const Unit& u, int wr, int wc, int fr, int fq) const {
        const int e = u.pn / npn, pnl = u.pn - e * npn;
        const int row0 = u.pm * BM + wr * 64 + fr; const int col0 = pnl * BM + wc * 32 + 8 * fq;
        f32x4 bv[2][2];
#pragma unroll
        for (int bj = 0; bj < 2; ++bj)
#pragma unroll
            for (int n = 0; n < 2; ++n) bv[bj][n] = bias ? *(const f32x4*)(bias + (size_t)e * bias_ld + col0 + bj * HALF + 4 * n) : (f32x4){0.f, 0.f, 0.f, 0.f};
#pragma unroll
        for (int ai = 0; ai < 2; ++ai)
#pragma unroll
            for (int m = 0; m < 4; ++m) { bf16_t* rowp = O + (size_t)(row0 + ai * HALF + m * 16) * ldc + col0;
#pragma unroll
                for (int bj = 0; bj < 2; ++bj) { const f32x4 v0 = acc[ai][bj][m][0] * scale + bv[bj][0], v1 = acc[ai][bj][m][1] * scale + bv[bj][1];
                    u32x4 w; w.x = cvt_pk_bf16(v0[0], v0[1]); w.y = cvt_pk_bf16(v0[2], v0[3]); w.z = cvt_pk_bf16(v1[0], v1[1]); w.w = cvt_pk_bf16(v1[2], v1[3]);
                    *(u32x4*)(rowp + bj * HALF) = w; } }
    }
};
struct EpiNone { static constexpr bool PERM = true; float* sink;
    __device__ __forceinline__ void operator()(const f32x4 (&acc)[2][2][4][2], const Unit& u, int wr, int wc, int fr, int fq) const {
        float t = 0.f;
#pragma unroll
        for (int ai = 0; ai < 2; ++ai)
#pragma unroll
            for (int bj = 0; bj < 2; ++bj)
#pragma unroll
                for (int m = 0; m < 4; ++m)
#pragma unroll
                    for (int n = 0; n < 2; ++n) t += acc[ai][bj][m][n][0];
        if (t == 123456.789f) *sink = t; } };
__device__ __forceinline__ float swiglu1(float g, float l) {
    g = fminf(g, 7.0f); l = fminf(fmaxf(l, -7.0f), 7.0f);
    const float s = __builtin_amdgcn_rcpf(1.0f + __expf(-1.702f * g));
    return g * s * (l + 1.0f);
}
__device__ __forceinline__ unsigned pk4_fp8(float a, float b, float c, float d) { int w = 0; w = __builtin_amdgcn_cvt_pk_fp8_f32(a, b, w, false); w = __builtin_amdgcn_cvt_pk_fp8_f32(c, d, w, true); return (unsigned)w; }
struct EpiSwiglu {
    static constexpr bool PERM = true;
    unsigned char* O; int ldc; const float* bias; int npn; int bias_ld; float scale;
    __device__ __forceinline__ void operator()(const f32x4 (&acc)[2][2][4][2], const Unit& u, int wr, int wc, int fr, int fq) const {
        const int e = u.pn / npn, pnl = u.pn - e * npn;
        const int row0 = u.pm * BM + wr * 64 + fr; const int col0 = pnl * BM + wc * 32 + 8 * fq;
        f32x4 bv[2][2];
#pragma unroll
        for (int bj = 0; bj < 2; ++bj)
#pragma unroll
            for (int n = 0; n < 2; ++n) bv[bj][n] = *(const f32x4*)(bias + (size_t)e * bias_ld + col0 + bj * HALF + 4 * n);
#pragma unroll
        for (int ai = 0; ai < 2; ++ai)
#pragma unroll
            for (int m = 0; m < 4; ++m) { unsigned char* rowp = O + (size_t)(row0 + ai * HALF + m * 16) * ldc + (col0 >> 1);
#pragma unroll
                for (int bj = 0; bj < 2; ++bj) { const f32x4 v0 = acc[ai][bj][m][0] * scale + bv[bj][0], v1 = acc[ai][bj][m][1] * scale + bv[bj][1];
                    *(unsigned*)(rowp + bj * (HALF / 2)) = pk4_fp8(swiglu1(v0[0], v0[1]), swiglu1(v0[2], v0[3]), swiglu1(v1[0], v1[1]), swiglu1(v1[2], v1[3])); } }
    }
};

constexpr int STG_PITCH = 528, STG8_PITCH = 144;
struct EpiBf16S {
    static constexpr bool PERM = true;
    bf16_t* O; int ldc; const float* bias; int npn; int bias_ld; float scale; LAS unsigned char* stg;
    __device__ __forceinline__ void operator()(const f32x4 (&acc)[2][2][4][2], const Unit& u, int wr, int wc, int fr, int fq) const {
        const int e = u.pn / npn, pnl = u.pn - e * npn; const int tid = threadIdx.x;
        const int col0 = pnl * BM + wc * 32 + 8 * fq;
        f32x4 bv[2][2];
#pragma unroll
        for (int bj = 0; bj < 2; ++bj)
#pragma unroll
            for (int n = 0; n < 2; ++n) bv[bj][n] = bias ? *(const f32x4*)(bias + (size_t)e * bias_ld + col0 + bj * HALF + 4 * n) : (f32x4){0.f, 0.f, 0.f, 0.f};
        LAS unsigned char* wp = stg + (16 * wr + fr) * STG_PITCH + 64 * wc + 16 * fq;
        const int rr = tid >> 4, cc = tid & 15; const LAS unsigned char* rp = stg + rr * STG_PITCH + cc * 16;
        bf16_t* gp = O + (size_t)(u.pm * BM + 64 * (rr >> 4) + (rr & 15)) * ldc + pnl * BM + cc * 8;
#pragma unroll
        for (int ai = 0; ai < 2; ++ai)
#pragma unroll
            for (int m = 0; m < 4; ++m) {
#pragma unroll
                for (int bj = 0; bj < 2; ++bj) { const f32x4 v0 = acc[ai][bj][m][0] * scale + bv[bj][0], v1 = acc[ai][bj][m][1] * scale + bv[bj][1];
                    u32x4 w; w.x = cvt_pk_bf16(v0[0], v0[1]); w.y = cvt_pk_bf16(v0[2], v0[3]); w.z = cvt_pk_bf16(v1[0], v1[1]); w.w = cvt_pk_bf16(v1[2], v1[3]);
                    *(LAS u32x4*)(wp + 256 * bj) = w; }
                asm volatile("s_waitcnt lgkmcnt(0)" ::: "memory"); __builtin_amdgcn_s_barrier(); asm volatile("" ::: "memory");
                bf16_t* g2 = gp + (size_t)(ai * HALF + m * 16) * ldc;
                *(u32x4*)(g2) = *(const LAS u32x4*)(rp); *(u32x4*)(g2 + HALF) = *(const LAS u32x4*)(rp + 256);
                asm volatile("s_waitcnt lgkmcnt(0)" ::: "memory"); __builtin_amdgcn_s_barrier(); asm volatile("" ::: "memory");
            }
    }
};
struct EpiSwigluS {
    static constexpr bool PERM = true;
    unsigned char* O; int ldc; const float* bias; int npn; int bias_ld; float scale; LAS unsigned char* stg;
    __device__ __forceinline__ void operator()(const f32x4 (&acc)[2][2][4][2], const Unit& u, int wr, int wc, int fr, int fq) const {
        const int e = u.pn / npn, pnl = u.pn - e * npn; const int tid = threadIdx.x;
        const int col0 = pnl * BM + wc * 32 + 8 * fq;
        f32x4 bv[2][2];
#pragma unroll
        for (int bj = 0; bj < 2; ++bj)
#pragma unroll
            for (int n = 0; n < 2; ++n) bv[bj][n] = *(const f32x4*)(bias + (size_t)e * bias_ld + col0 + bj * HALF + 4 * n);
        LAS unsigned char* wp = stg + (16 * wr + fr) * STG8_PITCH + 16 * wc + 4 * fq;
        const int rr = (tid >> 3) & 31, cc = tid & 7; const LAS unsigned char* rp = stg + rr * STG8_PITCH + cc * 16;
        unsigned char* gp = O + (size_t)(u.pm * BM + 64 * (rr >> 4) + (rr & 15)) * ldc + pnl * (BM / 2) + cc * 16;
#pragma unroll
        for (int ai = 0; ai < 2; ++ai)
#pragma unroll
            for (int m = 0; m < 4; ++m) {
#pragma unroll
                for (int bj = 0; bj < 2; ++bj) { const f32x4 v0 = acc[ai][bj][m][0] * scale + bv[bj][0], v1 = acc[ai][bj][m][1] * scale + bv[bj][1];
                    *(LAS unsigned*)(wp + 64 * bj) = pk4_fp8(swiglu1(v0[0], v0[1]), swiglu1(v0[2], v0[3]), swiglu1(v1[0], v1[1]), swiglu1(v1[2], v1[3])); }
                asm volatile("s_waitcnt lgkmcnt(0)" ::: "memory"); __builtin_amdgcn_s_barrier(); asm volatile("" ::: "memory");
                if (tid < 256) *(u32x4*)(gp + (size_t)(ai * HALF + m * 16) * ldc) = *(const LAS u32x4*)(rp);
                asm volatile("s_waitcnt lgkmcnt(0)" ::: "memory"); __builtin_amdgcn_s_barrier(); asm volatile("" ::: "memory");
            }
    }
};

struct GatherInfo { const int* elist; const LAS int* tab; const LAS int* rp; int npn; int nrep; int rcap; };
template <class Epi, class Sched, bool ALIGN_EPI, bool FP8, bool GATHER = false>
__device__ __forceinline__ void gemm_phase(LAS unsigned char* lds, const Gemm g, const Sched& S, const Epi& E, const GatherInfo GI = GatherInfo{nullptr, nullptr, nullptr, 1, 1, 0}) {
    const int tid = threadIdx.x, wid = __builtin_amdgcn_readfirstlane(tid >> 6), lane = tid & 63, wr = wid >> 2, wc = wid & 3, fr = lane & 15, fq = lane >> 4;
    const int RB = g.rowbytes, nt = RB / 128;
    unsigned voffA[2], voffB[2]; int rowA[2], colA2[2];
#pragma unroll
    for (int i = 0; i < 2; ++i) { int R, C; stage_rc(tid * 16 + i * 8192, R, C); const int Rb = Epi::PERM ? ((R & ~31) + perm32(R & 31)) : R;
        voffA[i] = (unsigned)(R * RB + C * 2); voffB[i] = (unsigned)(Rb * RB + C * 2); rowA[i] = R; colA2[i] = C * 2; }
    unsigned gc[2][2], gn[2][2];
#define PG8_GOFF(u_, go_) do { const int e_ = (u_).pn / GI.npn; const int base_ = (u_).pm * BM - GI.tab[e_]; const int cnt_ = GI.tab[64 + e_]; const LAS int* rp_ = GI.rp + e_ * GI.nrep; \
        _Pragma("unroll") for (int h_ = 0; h_ < 2; ++h_) _Pragma("unroll") for (int i_ = 0; i_ < 2; ++i_) { const int ii_ = base_ + 128 * h_ + rowA[i_]; int r_ = 0; \
            for (int j_ = 1; j_ < GI.nrep; ++j_) r_ += (rp_[j_] <= ii_) ? 1 : 0; \
            const int tok_ = ii_ < cnt_ ? GI.elist[((size_t)e_ * GI.nrep + r_) * GI.rcap + (ii_ - rp_[r_])] : 0; go_[h_][i_] = (unsigned)tok_ * (unsigned)RB + (unsigned)colA2[i_]; } } while (0)
#define PG8_STAGE_G(bufoff, go_, kb_) do { _Pragma("unroll") for (int _i = 0; _i < 2; ++_i) \
        __builtin_amdgcn_global_load_lds((const unsigned*)((const char*)g.A + (go_)[_i] + (kb_)), (LAS unsigned*)(lds + (bufoff) + ldsw + _i * 8192), 16, 0, 0); } while (0)
#define PG8_STAGE_A(bufoff, ptr_, h_, usenext_, kb_) do { if constexpr (GATHER) { unsigned o_[2] = { (usenext_) ? gn[h_][0] : gc[h_][0], (usenext_) ? gn[h_][1] : gc[h_][1] }; PG8_STAGE_G(bufoff, o_, kb_); } else { PG8_STAGE(bufoff, ptr_, voffA); } } while (0)
    const size_t kstep = 128;
    const size_t hstep = (size_t)HALF * RB;
    const size_t tstep = 2 * hstep;
    const unsigned ldsw = (unsigned)wid * 1024u;
    const int aoff = lds_byte(wr * 64 + fr, fq * 8), boff = lds_byte(wc * 32 + fr, fq * 8);
#define PG8_SA(b, h) (((b) * 2 + (h)) * HTB)
#define PG8_SB(b, h) ((4 + (b) * 2 + (h)) * HTB)
#define PG8_STAGE(bufoff, gbase, voff) do { _Pragma("unroll") for (int _i = 0; _i < 2; ++_i) \
        __builtin_amdgcn_global_load_lds((const unsigned*)((const char*)(gbase) + (voff)[_i]), (LAS unsigned*)(lds + (bufoff) + ldsw + _i * 8192), 16, 0, 0); } while (0)
    const LAS unsigned char* rdA = lds + aoff; const LAS unsigned char* rdB = lds + 4 * HTB + boff; asm volatile("" : "+v"(rdA), "+v"(rdB));
#define PG8_LD16A(off) (*(const LAS i32x4*)(rdA + (off)))
#define PG8_LD16B(off) (*(const LAS i32x4*)(rdB + (off)))
#define PG8_LDA(dst, b, h) do { _Pragma("unroll") for (int m = 0; m < 4; ++m) dst[m] = __builtin_shufflevector(PG8_LD16A(PG8_SA(b, h) + m * 2048), PG8_LD16A(PG8_SA(b, h) + m * 2048 + 1024), 0, 1, 2, 3, 4, 5, 6, 7); } while (0)
#define PG8_LDB(dst, b, h) do { _Pragma("unroll") for (int n = 0; n < 2; ++n) dst[n] = __builtin_shufflevector(PG8_LD16B(PG8_SB(b, h) - 4 * HTB + n * 2048), PG8_LD16B(PG8_SB(b, h) - 4 * HTB + n * 2048 + 1024), 0, 1, 2, 3, 4, 5, 6, 7); } while (0)
#define PG8_LO(x) __builtin_bit_cast(bf16x8, __builtin_shufflevector(x, x, 0, 1, 2, 3))
#define PG8_HI(x) __builtin_bit_cast(bf16x8, __builtin_shufflevector(x, x, 4, 5, 6, 7))
#define PG8_MMA(ai, bj, At, Bt) do { __builtin_amdgcn_s_setprio(1); _Pragma("unroll") for (int m = 0; m < 4; ++m) _Pragma("unroll") for (int n = 0; n < 2; ++n) { \
        if constexpr (FP8) asm volatile("v_mfma_scale_f32_16x16x128_f8f6f4 %0, %1, %2, %0, %3, %3 op_sel_hi:[0,0,0]" : "+v"(acc[ai][bj][m][n]) : "v"(Bt[n]), "v"(At[m]), "v"(sc1)); \
        else { acc[ai][bj][m][n] = __builtin_amdgcn_mfma_f32_16x16x32_bf16(PG8_LO(Bt[n]), PG8_LO(At[m]), acc[ai][bj][m][n], 0, 0, 0); \
               acc[ai][bj][m][n] = __builtin_amdgcn_mfma_f32_16x16x32_bf16(PG8_HI(Bt[n]), PG8_HI(At[m]), acc[ai][bj][m][n], 0, 0, 0); } } \
        __builtin_amdgcn_s_setprio(0); } while (0)
#define PG8_WAIT_V(n) asm volatile("s_waitcnt vmcnt(" #n ")" ::: "memory")
#define PG8_WAIT_L(n) asm volatile("s_waitcnt lgkmcnt(" #n ")" ::: "memory")
#define PG8_BAR __builtin_amdgcn_s_barrier()
#define PG8_SCHED __builtin_amdgcn_sched_barrier(0)
    Unit cur, nxt; int ui = 0;
    if (!S.next(0, cur)) return;
    f32x4 acc[2][2][4][2];
#pragma unroll
    for (int a = 0; a < 2; ++a)
#pragma unroll
        for (int b = 0; b < 2; ++b)
#pragma unroll
            for (int m = 0; m < 4; ++m)
#pragma unroll
                for (int n = 0; n < 2; ++n) acc[a][b][m][n] = (f32x4){0.f, 0.f, 0.f, 0.f};
    const int sc1 = 0x7f7f7f7f;
    i32x8 At[4], B0[2], B1[2];
    const char* cA = (const char*)g.A + (size_t)cur.pm * tstep; const char* cB = (const char*)g.Bt + (size_t)cur.pn * tstep;
    S.a_ready(cur);
    if constexpr (GATHER) { PG8_GOFF(cur, gc); }
    {
        PG8_STAGE(PG8_SB(0, 0), cB, voffB); PG8_STAGE(PG8_SB(0, 1), cB + hstep, voffB); PG8_STAGE_A(PG8_SA(0, 0), cA, 0, false, 0); PG8_STAGE_A(PG8_SA(0, 1), cA + hstep, 1, false, 0);
        if (wr == 1) PG8_BAR;
        PG8_WAIT_V(2); PG8_BAR;
        PG8_STAGE(PG8_SB(1, 0), cB + kstep, voffB); PG8_STAGE_A(PG8_SA(1, 0), cA + kstep, 0, false, 128); PG8_STAGE(PG8_SB(1, 1), cB + hstep + kstep, voffB);
        PG8_WAIT_V(6); PG8_BAR;
    }
    for (;;) {
        const bool has_next = S.next(ui + 1, nxt);
        const char* nA = has_next ? (const char*)g.A + (size_t)nxt.pm * tstep : cA; const char* nB = has_next ? (const char*)g.Bt + (size_t)nxt.pn * tstep : cB;
        if constexpr (GATHER) { if (has_next) { PG8_GOFF(nxt, gn); } else { gn[0][0] = gc[0][0]; gn[0][1] = gc[0][1]; gn[1][0] = gc[1][0]; gn[1][1] = gc[1][1]; } }
        for (int t = 0; t < nt; t += 2) {
            const bool last = (t == nt - 2);
            const char* a1 = cA + (size_t)(t + 1) * kstep;
            const char* a2 = last ? nA : cA + (size_t)(t + 2) * kstep; const char* b2 = last ? nB : cB + (size_t)(t + 2) * kstep;
            const char* a3 = a2 + kstep; const char* b3 = b2 + kstep;
            if (last && has_next) S.a_ready(nxt);
            PG8_LDB(B0, 0, 0); PG8_LDB(B1, 0, 1); PG8_SCHED; PG8_LDA(At, 0, 0); PG8_STAGE_A(PG8_SA(1, 1), a1 + hstep, 1, false, (unsigned)(t + 1) * 128u);
            PG8_WAIT_V(8); PG8_WAIT_L(0); PG8_BAR; PG8_MMA(0, 0, At, B0); PG8_MMA(0, 1, At, B1); PG8_BAR; PG8_SCHED;
            PG8_LDA(At, 0, 1); PG8_STAGE(PG8_SB(0, 0), b2, voffB); PG8_STAGE(PG8_SB(0, 1), b2 + hstep, voffB); PG8_STAGE_A(PG8_SA(0, 0), a2, 0, last, last ? 0u : (unsigned)(t + 2) * 128u);
            PG8_WAIT_V(8); PG8_WAIT_L(0); PG8_BAR; PG8_MMA(1, 0, At, B0); PG8_MMA(1, 1, At, B1); PG8_BAR; PG8_SCHED;
            PG8_LDB(B0, 1, 0); PG8_LDB(B1, 1, 1); PG8_SCHED; PG8_LDA(At, 1, 0); PG8_STAGE_A(PG8_SA(0, 1), a2 + hstep, 1, last, last ? 0u : (unsigned)(t + 2) * 128u);
            PG8_WAIT_V(8); PG8_WAIT_L(0); PG8_BAR; PG8_MMA(0, 0, At, B0); PG8_MMA(0, 1, At, B1); PG8_BAR; PG8_SCHED;
            PG8_LDA(At, 1, 1); PG8_STAGE(PG8_SB(1, 0), b3, voffB); PG8_STAGE(PG8_SB(1, 1), b3 + hstep, voffB); PG8_STAGE_A(PG8_SA(1, 0), a3, 0, last, last ? 128u : (unsigned)(t + 3) * 128u);
            PG8_WAIT_V(8); PG8_WAIT_L(0); PG8_BAR; PG8_MMA(1, 0, At, B0); PG8_MMA(1, 1, At, B1); PG8_BAR; PG8_SCHED;
        }
        if constexpr (ALIGN_EPI) { if (wr == 0) PG8_BAR; }
        if constexpr (FP8) asm volatile("s_nop 15\n\ts_nop 15" ::: "memory");
        E(acc, cur, wr, wc, fr, fq); S.done(cur);
        if (!has_next) break;
#pragma unroll
        for (int a = 0; a < 2; ++a)
#pragma unroll
            for (int b = 0; b < 2; ++b)
#pragma unroll
                for (int m = 0; m < 4; ++m)
#pragma unroll
                    for (int n = 0; n < 2; ++n) acc[a][b][m][n] = (f32x4){0.f, 0.f, 0.f, 0.f};
        cur = nxt; cA = nA; cB = nB; ++ui;
        if constexpr (GATHER) { gc[0][0] = gn[0][0]; gc[0][1] = gn[0][1]; gc[1][0] = gn[1][0]; gc[1][1] = gn[1][1]; }
        if constexpr (ALIGN_EPI) { if (wr == 1) PG8_BAR; }
    }
    PG8_WAIT_V(0);
    if constexpr (!ALIGN_EPI) { if (wr == 0) PG8_BAR; }
    PG8_BAR;
#undef PG8_SA
#undef PG8_SB
#undef PG8_STAGE
#undef PG8_STAGE_G
#undef PG8_STAGE_A
#undef PG8_GOFF
#undef PG8_LDA
#undef PG8_LD16A
#undef PG8_LD16B
#undef PG8_LO
#undef PG8_HI
#undef PG8_LDB
#undef PG8_MMA
#undef PG8_WAIT_V
#undef PG8_WAIT_L
#undef PG8_BAR
#undef PG8_SCHED
}
}

constexpr int D = 2048, NB = 4, T = 4096, TC = 256;
constexpr int M_LAT = NB * T, M_CTX = NB * TC, M_ALL = M_LAT + M_CTX;
constexpr int DC = 1024, DR = 1024, HS = 64, NH = 16, WL = 64, AL = 64, GL = 160;
constexpr int P_STATE = 2304, P_RWKV = 3488, P_IN = 6560, P_PAD = 6720, Q0 = 3 * DC;
constexpr int NE = 32, TOPK = 4, DE = 2048, EB = 256;
constexpr int MAXBLK = (M_LAT * TOPK) / EB + NE, NSLOT = MAXBLK * EB;
constexpr int NMOD = 6 * D;
constexpr float RMS_EPS = 1e-6f, LNX_EPS = 64e-5f, KK_EPS = 1e-24f;
constexpr int NWAVES = 8, NTHR = 512;
constexpr int RR = 16, RCAP = 2048;
constexpr float WSCALE = 64.0f;
constexpr int LOWW = 2 * WL + 2 * AL + GL, LOWP = LOWW + 8;

constexpr size_t MiB = 1u << 20;
constexpr size_t WS_CTL = 0, CTL_ZERO_BYTES = 1 * MiB;
constexpr size_t WS_MOD = 1 * MiB;
constexpr size_t WS_WIN = 2 * MiB;
constexpr size_t WS_WOUT = 28 * MiB;
constexpr size_t WS_WGU = 36 * MiB;
constexpr size_t WS_WDN = 548 * MiB;
constexpr size_t WS_H = 804 * MiB;
constexpr size_t WS_P = 872 * MiB;
constexpr size_t WS_SC = 1096 * MiB, SC_STRIDE = 68 * MiB;
constexpr size_t WS_SB = WS_SC + 2 * SC_STRIDE, SB_STRIDE = 34 * MiB;
enum { SB_KD = 0, SB_BB = 2, SB_NKK = 4, SB_V = 5, SB_R = 6 };
constexpr size_t WS_G = WS_SC + 9 * SC_STRIDE;
constexpr size_t WS_Y = WS_G + 64 * MiB;
constexpr size_t WS_MIXIN = WS_Y + 128 * MiB;
constexpr size_t WS_MIX = WS_MIXIN + 64 * MiB;
constexpr size_t WS_X1 = WS_MIX + 128 * MiB;
constexpr size_t WS_H2 = WS_X1 + 128 * MiB;
constexpr size_t WS_ROUTE = WS_H2 + 64 * MiB;
constexpr size_t WS_MODP = WS_ROUTE + 7 * MiB;
constexpr size_t WS_WT = WS_ROUTE + 6 * MiB;
constexpr size_t WS_XG = WS_ROUTE + 8 * MiB;
constexpr size_t WS_ACT = WS_XG + 288 * MiB;
constexpr size_t WS_YM = WS_ACT + 288 * MiB;
constexpr size_t WS_END = WS_YM + 288 * MiB;
constexpr int CW_TMO = 0, CW_BAR = 4096, CW_CNT = 8192;

constexpr int RING_BYTES = 131072, MISC_OFF = RING_BYTES, TAB_OFF = RING_BYTES + 256, RP_OFF = RING_BYTES + 768, LIST_OFF = RING_BYTES + 3072, STG_OFF = RING_BYTES + 4096, LDS_BYTES = STG_OFF + 32 * 528;

#define XB_TMO      128
#define XB_XCNT(j)  (256  + 64 * (j))
#define XB_XSUB(j)  (1280 + 64 * (j))
#define XB_XGEN(j)  (2304 + 64 * (j))
#define XB_TOP      3328
#define XB_TOPGEN   3392
#define XCD_BAR_WORDS 3456
#define XB_SPIN_CAP (1u << 18)
__device__ __forceinline__ unsigned xb_ld(unsigned* p)              { return __hip_atomic_load(p, __ATOMIC_RELAXED, __HIP_MEMORY_SCOPE_AGENT); }
__device__ __forceinline__ unsigned xb_add(unsigned* p, unsigned v) { return __hip_atomic_fetch_add(p, v, __ATOMIC_RELAXED, __HIP_MEMORY_SCOPE_AGENT); }
__device__ __forceinline__ unsigned xb_xcc_id() { return (unsigned)__builtin_amdgcn_s_getreg((3 << 11) | 20) & 0xFu; }
#define XB_SPIN(cond, bar) do { unsigned _sp = 0; while (cond) { __builtin_amdgcn_s_sleep(1); \
    if ((++_sp & 255u) == 0u) { if (xb_ld(&(bar)[XB_TMO])) break; if (_sp > XB_SPIN_CAP) { atomicAdd(&(bar)[XB_TMO], 1u); break; } } } } while (0)
struct XcdBarrier { unsigned* bar; unsigned x; volatile LAS unsigned* st; };
__device__ __forceinline__ XcdBarrier xcd_barrier_post(unsigned* bar, volatile LAS unsigned* st) {
    XcdBarrier b; b.bar = bar; b.x = xb_xcc_id(); b.st = st;
    if (threadIdx.x == 0) (void)xb_add(&bar[XB_XCNT(b.x)], 1u);
    return b;
}
__device__ __forceinline__ void xcd_barrier_complete(unsigned* bar, unsigned x, unsigned& nloc, unsigned& nx) {
    const unsigned G = gridDim.x * gridDim.y * gridDim.z;
    unsigned sum, cnt, mine, sp = 0u;
    for (;;) {
        sum = 0u; cnt = 0u; mine = 0u;
#pragma unroll
        for (unsigned j = 0; j < 16; ++j) { const unsigned c = xb_ld(&bar[XB_XCNT(j)]); sum += c; cnt += (c > 0u) ? 1u : 0u; mine = (j == x) ? c : mine; }
        if (sum == G) break;
        __builtin_amdgcn_s_sleep(1);
        if ((++sp & 255u) == 0u) { if (xb_ld(&bar[XB_TMO])) break; if (sp > XB_SPIN_CAP) { atomicAdd(&bar[XB_TMO], 1u); break; } }
    }
    nloc = mine > 0u ? mine : 1u; nx = cnt > 0u ? cnt : 1u;
}
__device__ __forceinline__ void xcd_barrier(const XcdBarrier& b) {
    asm volatile("s_waitcnt vmcnt(0)" ::: "memory");
    __syncthreads();
    if (threadIdx.x == 0) {
        unsigned* bar = b.bar;
        __builtin_amdgcn_s_waitcnt(0);
        unsigned nloc = b.st[0], nx = b.st[1];
        if (nloc == 0u) { xcd_barrier_complete(bar, b.x, nloc, nx); b.st[0] = nloc; b.st[1] = nx; }
        const unsigned old = xb_add(&bar[XB_XSUB(b.x)], 1u);
        const unsigned gen = old / nloc;
        if (old + 1u == (gen + 1u) * nloc) {
            __builtin_amdgcn_fence(__ATOMIC_RELEASE, "agent");
            asm volatile("s_waitcnt vmcnt(0)" ::: "memory");
            const unsigned og = xb_add(&bar[XB_TOP], 1u);
            const unsigned tg = og / nx;
            if (og + 1u == (tg + 1u) * nx) xb_add(&bar[XB_TOPGEN], 1u);
            else XB_SPIN(xb_ld(&bar[XB_TOPGEN]) == tg, bar);
            __builtin_amdgcn_fence(__ATOMIC_ACQUIRE, "agent");
            xb_add(&bar[XB_XGEN(b.x)], 1u);
            asm volatile("s_waitcnt vmcnt(0)" ::: "memory");
        } else {
            XB_SPIN(xb_ld(&bar[XB_XGEN(b.x)]) == gen, bar);
            __builtin_amdgcn_fence(__ATOMIC_ACQUIRE, "agent");
            asm volatile("s_waitcnt vmcnt(0)" ::: "memory");
        }
    }
    __syncthreads();
}

struct Frame {
    LAS unsigned char* lds;
    int tid, lane, wave, G, bx;
    const float* in[27];
    float* out; unsigned char* ws;
};
#define IN_X        (F.in[0])
#define IN_C        (F.in[1])
#define IN_CTX      (F.in[2])
#define IN_CCTX     (F.in[3])
#define IN_WMOD     (F.in[4])
#define IN_BMOD     (F.in[5])
#define IN_NORMG    (F.in[6])
#define IN_WIN      (F.in[7])
#define IN_CONVW    (F.in[8])
#define IN_MU       (F.in[9])
#define IN_W0       (F.in[10])
#define IN_WUP      (F.in[11])
#define IN_A0       (F.in[12])
#define IN_AUP      (F.in[13])
#define IN_KK       (F.in[14])
#define IN_KA       (F.in[15])
#define IN_RK       (F.in[16])
#define IN_LNXW     (F.in[17])
#define IN_LNXB     (F.in[18])
#define IN_GUP      (F.in[19])
#define IN_WOUT     (F.in[20])
#define IN_WROUTER  (F.in[21])
#define IN_BROUTER  (F.in[22])
#define IN_WGU      (F.in[23])
#define IN_BGU      (F.in[24])
#define IN_WDN      (F.in[25])
#define IN_BDN      (F.in[26])
#define WSP(T_, off) ((T_*)(F.ws + (off)))

#define LDS_WAIT() asm volatile("s_waitcnt lgkmcnt(0)" ::: "memory")
__device__ __forceinline__ float bf2f(bf16_t v) { return __builtin_bit_cast(float, (unsigned)v << 16); }
__device__ __forceinline__ unsigned f2bf(float f) { unsigned u = __builtin_bit_cast(unsigned, f); return (u + 0x7fffu + ((u >> 16) & 1u)) >> 16; }
__device__ __forceinline__ unsigned pk2(float lo, float hi) { return f2bf(lo) | (f2bf(hi) << 16); }
__device__ __forceinline__ float wave_sum(float v) {
#pragma unroll
    for (int o = 1; o < 64; o <<= 1) v += __shfl_xor(v, o);
    return v;
}
__device__ __forceinline__ float sigmoidf_(float x) { return __builtin_amdgcn_rcpf(1.0f + __expf(-x)); }

struct TrTile { const float* src; unsigned char* dst; int N, ncols, fp8; };
__device__ __forceinline__ TrTile p0_decode(Frame& F, int it) {
    constexpr int T_IN = 16 * (P_PAD / 256);
    const bool is_in = it < T_IN; const int r = is_in ? it : it - T_IN;
    const float* W = is_in ? IN_WIN : IN_WOUT; unsigned char* WT = is_in ? WSP(unsigned char, WS_WIN) : WSP(unsigned char, WS_WOUT); const int N = is_in ? P_IN : D;
    const int nblk = (N + 255) / 256, kb = r / nblk, nb = r % nblk;
    TrTile t; t.src = W + (size_t)(128 * kb) * N + 256 * nb; t.dst = WT + ((size_t)(256 * nb) * D + 128 * kb) * 2; t.N = N; t.ncols = (N - 256 * nb) < 256 ? (N - 256 * nb) : 256; t.fp8 = 0; return t;
}
#define P0_LOAD(v, t) do { const bool _ok = 4 * F.lane < (t).ncols; const float* _s = (t).src + (size_t)(16 * F.wave) * (t).N + 4 * F.lane; \
    _Pragma("unroll") for (int i = 0; i < 16; ++i) v[i] = _ok ? *(const f32x4*)(_s + (size_t)i * (t).N) : (f32x4){0.f, 0.f, 0.f, 0.f}; } while (0)
__device__ __forceinline__ void p0_store_tile(Frame& F, const f32x4 (&v)[16], const TrTile& t) {
    LAS unsigned char* tile = F.lds;
    if (t.fp8) {
#pragma unroll
        for (int j = 0; j < 4; ++j) { const int n = 4 * F.lane + j; u32x4 w;
            w.x = pg8::pk4_fp8(v[0][j] * WSCALE, v[1][j] * WSCALE, v[2][j] * WSCALE, v[3][j] * WSCALE); w.y = pg8::pk4_fp8(v[4][j] * WSCALE, v[5][j] * WSCALE, v[6][j] * WSCALE, v[7][j] * WSCALE);
            w.z = pg8::pk4_fp8(v[8][j] * WSCALE, v[9][j] * WSCALE, v[10][j] * WSCALE, v[11][j] * WSCALE); w.w = pg8::pk4_fp8(v[12][j] * WSCALE, v[13][j] * WSCALE, v[14][j] * WSCALE, v[15][j] * WSCALE);
            *(LAS u32x4*)(tile + n * 128 + ((F.wave ^ ((n >> 2) & 7)) << 4)) = w; }
        __syncthreads();
#pragma unroll
        for (int j = 0; j < 4; ++j) { const int n = 32 * F.wave + (F.lane >> 3) + 8 * j, c = F.lane & 7;
            if (n < t.ncols) *(u32x4*)(t.dst + (size_t)n * D + 16 * c) = *(const LAS u32x4*)(tile + n * 128 + ((c ^ ((n >> 2) & 7)) << 4)); }
        __syncthreads();
        return;
    }
#pragma unroll
    for (int j = 0; j < 4; ++j) { const int n = 4 * F.lane + j;
#pragma unroll
        for (int hc = 0; hc < 2; ++hc) { u32x4 w;
            w.x = pg8::cvt_pk_bf16(v[8 * hc + 0][j], v[8 * hc + 1][j]); w.y = pg8::cvt_pk_bf16(v[8 * hc + 2][j], v[8 * hc + 3][j]);
            w.z = pg8::cvt_pk_bf16(v[8 * hc + 4][j], v[8 * hc + 5][j]); w.w = pg8::cvt_pk_bf16(v[8 * hc + 6][j], v[8 * hc + 7][j]);
            *(LAS u32x4*)(tile + n * 256 + (((2 * F.wave + hc) ^ ((n >> 2) & 15)) << 4)) = w; } }
    __syncthreads();
#pragma unroll
    for (int j = 0; j < 8; ++j) { const int n = 32 * F.wave + (F.lane >> 4) + 4 * j, c = F.lane & 15;
        if (n < t.ncols) *(u32x4*)(t.dst + ((size_t)n * D + 8 * c) * 2) = *(const LAS u32x4*)(tile + n * 256 + ((c ^ ((n >> 2) & 15)) << 4)); }
    __syncthreads();
}
__device__ __forceinline__ void p0_prologue(Frame& F) {
    for (int u = F.bx; u < (NMOD / 256) * 4; u += F.G) {
        const int nb = u >> 2, kq = u & 3;
        LAS float* sl = (LAS float*)F.lds;
        LAS float* red = (LAS float*)(F.lds + 16384);
        __syncthreads();
        for (int i = F.tid; i < 5 * 512; i += NTHR) { const int r = i >> 9, k = 512 * kq + (i & 511); const float cv = r < 4 ? IN_C[r * D + k] : IN_CCTX[k]; sl[i] = cv / (1.0f + __expf(-cv)); }
        __syncthreads();
        f32x4 acc[5];
#pragma unroll
        for (int r = 0; r < 5; ++r) acc[r] = (f32x4){0.f, 0.f, 0.f, 0.f};
        const int kl = F.wave * 64;
        const float* wp = IN_WMOD + (size_t)(512 * kq + kl) * NMOD + nb * 256 + F.lane * 4;
#pragma unroll 16
        for (int k = 0; k < 64; ++k) { const f32x4 w = *(const f32x4*)(wp + (size_t)k * NMOD);
#pragma unroll
            for (int r = 0; r < 5; ++r) acc[r] += sl[r * 512 + kl + k] * w; }
#pragma unroll
        for (int r = 0; r < 5; ++r) *(LAS f32x4*)(red + (F.wave * 5 + r) * 256 + F.lane * 4) = acc[r];
        __syncthreads();
        float* modp = WSP(float, WS_MODP) + (size_t)kq * 5 * NMOD;
        for (int o = F.tid; o < 5 * 256; o += NTHR) { const int r = o / 256, col = o % 256; float s = 0.f;
#pragma unroll
            for (int w = 0; w < 8; ++w) s += red[(w * 5 + r) * 256 + col];
            modp[r * NMOD + nb * 256 + col] = s; }
        __syncthreads();
    }
    {
        constexpr int NTILES = 16 * (P_PAD / 256) + 16 * (D / 256);
        f32x4 va[16], vb[16];
        int it = F.bx;
        TrTile ta, tb; ta = p0_decode(F, it < NTILES ? it : 0); tb = ta;
        if (it < NTILES) P0_LOAD(va, ta);
        while (it < NTILES) {
            const int it1 = it + F.G;
            if (it1 < NTILES) { tb = p0_decode(F, it1); P0_LOAD(vb, tb); }
            p0_store_tile(F, va, ta);
            if (it1 >= NTILES) break;
            const int it2 = it1 + F.G;
            if (it2 < NTILES) { ta = p0_decode(F, it2); P0_LOAD(va, ta); }
            p0_store_tile(F, vb, tb);
            it = it2;
        }
    }
    {
        bf16_t* WT = WSP(bf16_t, WS_WT);
        for (int idx = F.bx * NTHR + F.tid; idx < LOWW * DR; idx += F.G * NTHR) { const int j = idx / DR, c = idx % DR;
            const float v = j < 128 ? IN_WUP[(size_t)j * DR + c] : j < 256 ? IN_AUP[(size_t)(j - 128) * DR + c] : IN_GUP[(size_t)(j - 256) * DR + c];
            WT[(size_t)c * LOWW + j] = (bf16_t)f2bf(v); }
    }
}

__device__ __forceinline__ void p1_norm(Frame& F) {
    const float* modp = WSP(float, WS_MODP); float* mod = WSP(float, WS_MOD); bf16_t* H = WSP(bf16_t, WS_H);
    for (int idx = F.bx * NTHR + F.tid; idx < 5 * NMOD; idx += F.G * NTHR)
        mod[idx] = ((modp[idx] + modp[5 * NMOD + idx]) + (modp[2 * 5 * NMOD + idx] + modp[3 * 5 * NMOD + idx])) + IN_BMOD[idx % NMOD];
    LAS float* gs = (LAS float*)F.lds;
    LAS float* sh = gs + D;
    const int rpw = (M_ALL + F.G - 1) / F.G, r0 = F.bx * rpw, r1 = (r0 + rpw) < M_ALL ? (r0 + rpw) : M_ALL;
    int cur = -1;
    for (int rb = r0; rb < r1; rb += NWAVES) {
        const int b0 = rb < M_LAT ? rb / T : 4;
        if (b0 != cur) {
            __syncthreads();
            for (int c = F.tid; c < D; c += NTHR) { const int i0 = b0 * NMOD + c, i1 = b0 * NMOD + D + c;
                const float shv = ((modp[i0] + modp[5 * NMOD + i0]) + (modp[2 * 5 * NMOD + i0] + modp[3 * 5 * NMOD + i0])) + IN_BMOD[c];
                const float scv = ((modp[i1] + modp[5 * NMOD + i1]) + (modp[2 * 5 * NMOD + i1] + modp[3 * 5 * NMOD + i1])) + IN_BMOD[D + c];
                gs[c] = IN_NORMG[c] * (1.0f + scv); sh[c] = shv; }
            __syncthreads();
            cur = b0;
        }
        const int row = rb + F.wave;
        const int bw = row < M_LAT ? row / T : 4;
        if (row < r1 && bw == b0) {
            const float* xr = row < M_LAT ? IN_X + (size_t)row * D : IN_CTX + (size_t)(row - M_LAT) * D;
            f32x4 v[8]; float ss = 0.f;
#pragma unroll
            for (int j = 0; j < 8; ++j) { v[j] = *(const f32x4*)(xr + 4 * F.lane + 256 * j); ss += (v[j].x * v[j].x + v[j].y * v[j].y) + (v[j].z * v[j].z + v[j].w * v[j].w); }
            const float rstd = 1.0f / sqrtf(wave_sum(ss) * (1.0f / D) + RMS_EPS);
#pragma unroll
            for (int j = 0; j < 8; ++j) { const int c = 4 * F.lane + 256 * j;
                const f32x4 o = (v[j] * rstd) * *(const LAS f32x4*)(gs + c) + *(const LAS f32x4*)(sh + c);
                u32x2 w; w.x = pg8::cvt_pk_bf16(o.x, o.y); w.y = pg8::cvt_pk_bf16(o.z, o.w);
                *(u32x2*)(H + (size_t)row * D + c) = w; }
        }
        if (rb + NWAVES - 1 < r1 || true) { const int lastrow = (rb + NWAVES - 1) < r1 ? (rb + NWAVES - 1) : (r1 - 1); const int bl = lastrow < M_LAT ? lastrow / T : 4;
            if (bl != b0) {
                __syncthreads();
                for (int c = F.tid; c < D; c += NTHR) { const int i0 = bl * NMOD + c, i1 = bl * NMOD + D + c;
                    const float shv = ((modp[i0] + modp[5 * NMOD + i0]) + (modp[2 * 5 * NMOD + i0] + modp[3 * 5 * NMOD + i0])) + IN_BMOD[c];
                    const float scv = ((modp[i1] + modp[5 * NMOD + i1]) + (modp[2 * 5 * NMOD + i1] + modp[3 * 5 * NMOD + i1])) + IN_BMOD[D + c];
                    gs[c] = IN_NORMG[c] * (1.0f + scv); sh[c] = shv; }
                __syncthreads();
                cur = bl;
                if (row < r1 && bw == bl) {
                    const float* xr = row < M_LAT ? IN_X + (size_t)row * D : IN_CTX + (size_t)(row - M_LAT) * D;
                    f32x4 v[8]; float ss = 0.f;
#pragma unroll
                    for (int j = 0; j < 8; ++j) { v[j] = *(const f32x4*)(xr + 4 * F.lane + 256 * j); ss += (v[j].x * v[j].x + v[j].y * v[j].y) + (v[j].z * v[j].z + v[j].w * v[j].w); }
                    const float rstd = 1.0f / sqrtf(wave_sum(ss) * (1.0f / D) + RMS_EPS);
#pragma unroll
                    for (int j = 0; j < 8; ++j) { const int c = 4 * F.lane + 256 * j;
                        const f32x4 o = (v[j] * rstd) * *(const LAS f32x4*)(gs + c) + *(const LAS f32x4*)(sh + c);
                        u32x2 w; w.x = pg8::cvt_pk_bf16(o.x, o.y); w.y = pg8::cvt_pk_bf16(o.z, o.w);
                        *(u32x2*)(H + (size_t)row * D + c) = w; }
                }
            }
        }
    }
}

__device__ __forceinline__ void static_unit(int L, int nM, int nN, int& pm, int& pn) {
    const int nwg = nM * nN; int wgid = L;
    { const int q = nwg / 8, r = nwg % 8, xcd = wgid % 8, off = wgid / 8; wgid = (xcd < r ? xcd * (q + 1) : r * (q + 1) + (xcd - r) * q) + off; }
    const int nig = 8 * nN, gid = wgid / nig, fm = gid * 8, gsz = (nM - fm) < 8 ? (nM - fm) : 8;
    pm = fm + ((wgid % nig) % gsz); pn = (wgid % nig) / gsz;
}
__device__ __forceinline__ void build_tab(Frame& F) {
    LAS int* tab = (LAS int*)(F.lds + TAB_OFF); LAS int* rp = (LAS int*)(F.lds + RP_OFF);
    if (F.tid < NE) { const unsigned* cnt = WSP(unsigned, WS_CTL) + CW_CNT; int run = 0;
#pragma unroll
        for (int r = 0; r < RR; ++r) { rp[F.tid * RR + r] = run; run += (int)__hip_atomic_load(cnt + (r * NE + F.tid) * 16, __ATOMIC_RELAXED, __HIP_MEMORY_SCOPE_AGENT); }
        tab[64 + F.tid] = run; }
    __syncthreads();
    if (F.tid == 0) { int run = 0;
        for (int e = 0; e < NE; ++e) { tab[e] = run; run += ((tab[64 + e] + EB - 1) / EB) * EB; }
        tab[32] = run; }
    __syncthreads();
}
__device__ __forceinline__ int build_list(Frame& F, int mode) {
    LAS int* list = (LAS int*)(F.lds + LIST_OFF); const LAS int* tab = (const LAS int*)(F.lds + TAB_OFF);
    int total;
    if (mode == 0) total = 64 * 26 + 4 * 9; else if (mode == 1) total = 64 * 8; else total = (tab[32] / EB) * (mode == 2 ? 16 : 8);
    const int c = F.bx; const int n = c < total ? (total - c + F.G - 1) / F.G : 0;
    if (F.tid < n && F.tid < 64) {
        const int L = F.tid * F.G + c; int pm, pn;
        if (mode == 0) { if (L < 64 * 26) static_unit(L, 64, 26, pm, pn); else { const int r = L - 64 * 26; pm = 64 + (r & 3); pn = 12 + (r >> 2); } }
        else if (mode == 1) static_unit(L, 64, 8, pm, pn);
        else { const int NT = mode == 2 ? 16 : 8; int wgid = L;
            { const int q = total / 8, r = total % 8, xcd = wgid % 8, off = wgid / 8; wgid = (xcd < r ? xcd * (q + 1) : r * (q + 1) + (xcd - r) * q) + off; }
            int e = 0, ustart = 0;
            for (; e < NE - 1; ++e) { const int nb = (tab[e + 1] - tab[e]) / EB; if (wgid < ustart + nb * NT) break; ustart += nb * NT; }
            const int nb = (tab[e + 1] - tab[e]) / EB, re = wgid - ustart, j = re / (8 * NT), r = re - j * 8 * NT, gsz = (nb - 8 * j) < 8 ? (nb - 8 * j) : 8;
            pm = tab[e] / EB + 8 * j + r % gsz; pn = e * NT + r / gsz; }
        list[2 * F.tid] = pm; list[2 * F.tid + 1] = pn;
    }
    __syncthreads();
    return n < 64 ? n : 64;
}

__device__ __forceinline__ float qshift(const bf16_t* p, int gr, int s0, int s1, int col, float mu0, float mu1) {
    const float c = bf2f(p[(size_t)gr * P_PAD + Q0 + col]);
    const float pv = gr > s0 ? bf2f(p[(size_t)(gr - 1) * P_PAD + Q0 + col]) : 0.f;
    const float nx = gr + 1 < s1 ? bf2f(p[(size_t)(gr + 1) * P_PAD + Q0 + col]) : 0.f;
    return c + mu0 * (pv - c) + mu1 * (nx - c);
}
__device__ __forceinline__ f32x4 ld_bf4(const bf16_t* p) { const u32x2 w = *(const u32x2*)p; return (f32x4){__builtin_bit_cast(float, w.x << 16), __builtin_bit_cast(float, w.x & 0xffff0000u), __builtin_bit_cast(float, w.y << 16), __builtin_bit_cast(float, w.y & 0xffff0000u)}; }
__device__ __forceinline__ void ld_bf8(const bf16_t* p, f32x4& lo, f32x4& hi) { const u32x4 w = *(const u32x4*)p;
    lo = (f32x4){__builtin_bit_cast(float, w.x << 16), __builtin_bit_cast(float, w.x & 0xffff0000u), __builtin_bit_cast(float, w.y << 16), __builtin_bit_cast(float, w.y & 0xffff0000u)};
    hi = (f32x4){__builtin_bit_cast(float, w.z << 16), __builtin_bit_cast(float, w.z & 0xffff0000u), __builtin_bit_cast(float, w.w << 16), __builtin_bit_cast(float, w.w & 0xffff0000u)}; }
__device__ __forceinline__ f32x4 qshift4(const bf16_t* P, const float* mu, int gr, bool hp, bool hn, int col) {
    const bf16_t* pr = P + (size_t)gr * P_PAD + Q0 + col;
    const f32x4 c = ld_bf4(pr); const f32x4 z = (f32x4){0.f, 0.f, 0.f, 0.f};
    const f32x4 pv = hp ? ld_bf4(pr - P_PAD) : z, nx = hn ? ld_bf4(pr + P_PAD) : z;
    const f32x4 m0 = *(const f32x4*)(mu + col), m1 = *(const f32x4*)(mu + P_RWKV + col);
    return c + m0 * (pv - c) + m1 * (nx - c);
}
__device__ __forceinline__ void st_bf4(bf16_t* p, f32x4 v) { u32x2 w; w.x = pg8::cvt_pk_bf16(v.x, v.y); w.y = pg8::cvt_pk_bf16(v.z, v.w); *(u32x2*)p = w; }
__device__ __forceinline__ f32x4 sig4(f32x4 x) { return (f32x4){sigmoidf_(x.x), sigmoidf_(x.y), sigmoidf_(x.z), sigmoidf_(x.w)}; }
__device__ __forceinline__ void st_bf8(bf16_t* p, f32x4 a, f32x4 b) { u32x4 w; w.x = pg8::cvt_pk_bf16(a.x, a.y); w.y = pg8::cvt_pk_bf16(a.z, a.w); w.z = pg8::cvt_pk_bf16(b.x, b.y); w.w = pg8::cvt_pk_bf16(b.z, b.w); *(u32x4*)p = w; }
__device__ __forceinline__ void qshift16(const bf16_t* P, int gr, bool hp, bool hn, int col, const LAS float* mu0, const LAS float* mu1, f32x4 (&o)[4]) {
    const bf16_t* pr = P + (size_t)gr * P_PAD + Q0 + col;
    f32x4 c[4], pv[4], nx[4]; const f32x4 z = (f32x4){0.f, 0.f, 0.f, 0.f};
    ld_bf8(pr, c[0], c[1]); ld_bf8(pr + 8, c[2], c[3]);
    if (hp) { ld_bf8(pr - P_PAD, pv[0], pv[1]); ld_bf8(pr - P_PAD + 8, pv[2], pv[3]); } else { pv[0] = z; pv[1] = z; pv[2] = z; pv[3] = z; }
    if (hn) { ld_bf8(pr + P_PAD, nx[0], nx[1]); ld_bf8(pr + P_PAD + 8, nx[2], nx[3]); } else { nx[0] = z; nx[1] = z; nx[2] = z; nx[3] = z; }
#pragma unroll
    for (int n = 0; n < 4; ++n) o[n] = c[n] + *(const LAS f32x4*)(mu0 + 4 * n) * (pv[n] - c[n]) + *(const LAS f32x4*)(mu1 + 4 * n) * (nx[n] - c[n]);
}
__device__ __forceinline__ void p3_inputs(Frame& F) {
    LAS bf16_t* low = (LAS bf16_t*)F.lds;
    LAS float* par = (LAS float*)(F.lds + 16384) + F.wave * (2 * 12 * 64);
    const bf16_t* P = WSP(bf16_t, WS_P); const float* mu = IN_MU; const bf16_t* WT = WSP(bf16_t, WS_WT);
    bf16_t* Ub = WSP(bf16_t, WS_SC); bf16_t* SBb = WSP(bf16_t, WS_SB); bf16_t* G = WSP(bf16_t, WS_G);
    const int tok = F.lane & 15, q = F.lane >> 4;
#pragma unroll
    for (int hh = 0; hh < 2; ++hh) { const int ch = (2 * F.wave + hh) * 64 + F.lane; LAS float* pp = par + hh * 12 * 64 + F.lane;
        pp[0 * 64] = IN_KK[ch]; pp[1 * 64] = IN_KA[ch]; pp[2 * 64] = IN_W0[ch]; pp[3 * 64] = IN_W0[DR + ch]; pp[4 * 64] = IN_A0[ch]; pp[5 * 64] = IN_A0[DR + ch];
        pp[6 * 64] = mu[ch]; pp[7 * 64] = mu[P_RWKV + ch]; pp[8 * 64] = mu[1024 + ch]; pp[9 * 64] = mu[P_RWKV + 1024 + ch]; pp[10 * 64] = mu[2304 + ch]; pp[11 * 64] = mu[P_RWKV + 2304 + ch]; }
    for (int tile = F.bx; tile < M_ALL / 16; tile += F.G) {
        const int row0 = tile * 16; int s0, s1;
        if (row0 < M_LAT) { s0 = (row0 / T) * T; s1 = s0 + T; } else { s0 = M_LAT + ((row0 - M_LAT) / TC) * TC; s1 = s0 + TC; }
        const bool lat = row0 < M_LAT;
        __syncthreads();
        for (int i = F.tid; i < 16 * (LOWW / 4); i += NTHR) { const int tk = i / (LOWW / 4), c4 = (i % (LOWW / 4)) * 4, col = c4 < 256 ? 2048 + c4 : 3328 + (c4 - 256);
            f32x4 qv = qshift4(P, mu, row0 + tk, row0 + tk > s0, row0 + tk + 1 < s1, col);
            if (c4 < 128) qv = (f32x4){1.0f - 2.0f * __builtin_amdgcn_rcpf(1.0f + __expf(2.0f * qv.x)), 1.0f - 2.0f * __builtin_amdgcn_rcpf(1.0f + __expf(2.0f * qv.y)), 1.0f - 2.0f * __builtin_amdgcn_rcpf(1.0f + __expf(2.0f * qv.z)), 1.0f - 2.0f * __builtin_amdgcn_rcpf(1.0f + __expf(2.0f * qv.w))};
            else if (c4 >= 256) qv = sig4(qv);
            u32x2 w; w.x = pg8::cvt_pk_bf16(qv.x, qv.y); w.y = pg8::cvt_pk_bf16(qv.z, qv.w); *(LAS u32x2*)(low + tk * LOWP + c4) = w; }
        __syncthreads();
        bf16x8 af[13];
#pragma unroll
        for (int s = 0; s < 13; ++s) af[s] = *(const LAS bf16x8*)(low + tok * LOWP + 32 * s + 8 * q);
        const int gr = row0 + tok; const bool hp = gr > s0, hn = gr + 1 < s1;
#pragma unroll 1
        for (int hh = 0; hh < 2; ++hh) {
            const int head = 2 * F.wave + hh; const int cb = head * 64 + 16 * q;
            const LAS float* pl = par + hh * 12 * 64 + 16 * q;
            f32x4 acc[4][5];
#pragma unroll
            for (int n = 0; n < 4; ++n) {
                const bf16_t* wrow = WT + (size_t)(head * 64 + 16 * (tok >> 2) + 4 * n + (tok & 3)) * LOWW + 8 * q;
#pragma unroll
                for (int x = 0; x < 5; ++x) acc[n][x] = (f32x4){0.f, 0.f, 0.f, 0.f};
#pragma unroll
                for (int s = 0; s < 13; ++s) { const bf16x8 bw = *(const bf16x8*)(wrow + 32 * s); const int x = s < 8 ? (s >> 1) : 4;
                    acc[n][x] = __builtin_amdgcn_mfma_f32_16x16x32_bf16(bw, af[s], acc[n][x], 0, 0, 0); }
            }
            const size_t o = (size_t)gr * DR + cb;
            f32x4 k[4]; qshift16(P, gr, hp, hn, cb, pl + 6 * 64, pl + 7 * 64, k);
            f32x4 kr[4]; float ss = 0.f;
#pragma unroll
            for (int n = 0; n < 4; ++n) { kr[n] = k[n] * *(const LAS f32x4*)(pl + 0 * 64 + 4 * n); ss += (kr[n].x * kr[n].x + kr[n].y * kr[n].y) + (kr[n].z * kr[n].z + kr[n].w * kr[n].w); }
            ss += __shfl_xor(ss, 16); ss += __shfl_xor(ss, 32);
            const float rn = 1.0f / sqrtf(fmaxf(ss, KK_EPS));
#pragma unroll
            for (int n = 0; n < 4; ++n) kr[n] = kr[n] * rn;
            st_bf8(SBb + (size_t)SB_NKK * (SB_STRIDE / 2) + o, -kr[0], -kr[1]); st_bf8(SBb + (size_t)SB_NKK * (SB_STRIDE / 2) + o + 8, -kr[2], -kr[3]);
#pragma unroll
            for (int d = 0; d < 2; ++d) {
                f32x4 uu[4], kd[4], bb[4];
#pragma unroll
                for (int n = 0; n < 4; ++n) {
                    uu[n] = sig4(acc[n][d] + *(const LAS f32x4*)(pl + (2 + d) * 64 + 4 * n)) * 0.60653066f;
                    const f32x4 a = sig4(acc[n][2 + d] + *(const LAS f32x4*)(pl + (4 + d) * 64 + 4 * n));
                    kd[n] = k[n] * ((a - 1.0f) * *(const LAS f32x4*)(pl + 1 * 64 + 4 * n) + 1.0f); bb[n] = kr[n] * a; }
                st_bf8(Ub + (size_t)d * (SC_STRIDE / 2) + o, uu[0], uu[1]); st_bf8(Ub + (size_t)d * (SC_STRIDE / 2) + o + 8, uu[2], uu[3]);
                st_bf8(SBb + (size_t)(SB_KD + d) * (SB_STRIDE / 2) + o, kd[0], kd[1]); st_bf8(SBb + (size_t)(SB_KD + d) * (SB_STRIDE / 2) + o + 8, kd[2], kd[3]);
                st_bf8(SBb + (size_t)(SB_BB + d) * (SB_STRIDE / 2) + o, bb[0], bb[1]); st_bf8(SBb + (size_t)(SB_BB + d) * (SB_STRIDE / 2) + o + 8, bb[2], bb[3]);
            }
            if (lat) { st_bf8(G + o, acc[0][4], acc[1][4]); st_bf8(G + o + 8, acc[2][4], acc[3][4]); }
            { f32x4 v[4]; qshift16(P, gr, hp, hn, 1024 + cb, pl + 8 * 64, pl + 9 * 64, v);
              st_bf8(SBb + (size_t)SB_V * (SB_STRIDE / 2) + o, v[0], v[1]); st_bf8(SBb + (size_t)SB_V * (SB_STRIDE / 2) + o + 8, v[2], v[3]); }
            { f32x4 r[4]; qshift16(P, gr, hp, hn, 2304 + cb, pl + 10 * 64, pl + 11 * 64, r);
              st_bf8(SBb + (size_t)SB_R * (SB_STRIDE / 2) + o, r[0], r[1]); st_bf8(SBb + (size_t)SB_R * (SB_STRIDE / 2) + o + 8, r[2], r[3]); }
        }
    }
    __syncthreads();
}

__device__ __forceinline__ float fma_(float a, float b, float c) { float d; asm("v_fma_f32 %0, %1, %2, %3" : "=v"(d) : "v"(a), "v"(b), "v"(c)); return d; }
__device__ __forceinline__ float mul_(float a, float b) { float d; asm("v_mul_f32 %0, %1, %2" : "=v"(d) : "v"(a), "v"(b)); return d; }
__device__ __forceinline__ float add_(float a, float b) { float d; asm("v_add_f32 %0, %1, %2" : "=v"(d) : "v"(a), "v"(b)); return d; }
template <int OFF> __device__ __forceinline__ f32x4 lds_rd128(unsigned addr) { f32x4 v; asm volatile("ds_read_b128 %0, %1 offset:%2" : "=&v"(v) : "v"(addr), "n"(OFF)); return v; }
template <int OFF> __device__ __forceinline__ float lds_rd32(unsigned addr) { float v; asm volatile("ds_read_b32 %0, %1 offset:%2" : "=&v"(v) : "v"(addr), "n"(OFF)); return v; }
__device__ __forceinline__ f32x2 pk_mul(f32x2 a, f32x2 b) { f32x2 d; asm("v_pk_mul_f32 %0, %1, %2" : "=v"(d) : "v"(a), "v"(b)); return d; }
__device__ __forceinline__ f32x2 pk_fma(f32x2 a, f32x2 b, f32x2 c) { f32x2 d; asm("v_pk_fma_f32 %0, %1, %2, %3" : "=v"(d) : "v"(a), "v"(b), "v"(c)); return d; }
__device__ __forceinline__ f32x2 pk_mul_b0(f32x2 a, f32x2 b) { f32x2 d; asm("v_pk_mul_f32 %0, %1, %2 op_sel_hi:[0,1]" : "=v"(d) : "v"(a), "v"(b)); return d; }
__device__ __forceinline__ f32x2 pk_fma_b0(f32x2 a, f32x2 b, f32x2 c) { f32x2 d; asm("v_pk_fma_f32 %0, %1, %2, %3 op_sel_hi:[0,1,1]" : "=v"(d) : "v"(a), "v"(b), "v"(c)); return d; }
#define LO2(v4) __builtin_shufflevector(v4, v4, 0, 1)
#define HI2(v4) __builtin_shufflevector(v4, v4, 2, 3)
template <int CTRL> __device__ __forceinline__ float dpp_add(float x) { return x + __builtin_bit_cast(float, __builtin_amdgcn_update_dpp(0, __builtin_bit_cast(int, x), CTRL, 0xF, 0xF, true)); }
__device__ __forceinline__ float row16_sum(float x) { x = dpp_add<0xB1>(x); x = dpp_add<0x4E>(x); x = dpp_add<0x124>(x); x = dpp_add<0x128>(x); return x; }
__device__ __forceinline__ int scan_row(int step, int b, int d) {
    if (step < TC) { const int t = d ? TC - 1 - step : step; return M_LAT + b * TC + t; }
    int t = step - TC; t = d ? T - 1 - t : t; return b * T + t;
}
struct CvItem { const float* src; unsigned char* dst; int N; };
constexpr int CV_GU1 = (D / 128) * (2 * DE / 32), CV_DN1 = (DE / 128) * (D / 32), CV_ITEMS = NE * (CV_GU1 + CV_DN1);
__device__ __forceinline__ CvItem cv_decode(Frame& F, int it) {
    const float* W; unsigned char* WT; int N, row_off, r;
    if (it < NE * CV_GU1) { const int e = it / CV_GU1; r = it - e * CV_GU1; W = IN_WGU + (size_t)e * D * 2 * DE; WT = WSP(unsigned char, WS_WGU); N = 2 * DE; row_off = e * 2 * DE; }
    else { it -= NE * CV_GU1; const int e = it / CV_DN1; r = it - e * CV_DN1; W = IN_WDN + (size_t)e * DE * D; WT = WSP(unsigned char, WS_WDN); N = D; row_off = e * D; }
    const int nblk = N / 32, kb = r / nblk, nb = r % nblk;
    CvItem t; t.src = W + (size_t)(128 * kb) * N + 32 * nb; t.dst = WT + (size_t)(row_off + 32 * nb) * D + 128 * kb; t.N = N; return t;
}
#define CV_LOAD(v, t, lane_) do { const float* _s = (t).src + (size_t)(16 * ((lane_) >> 3)) * (t).N + 4 * ((lane_) & 7); \
    _Pragma("unroll") for (int i = 0; i < 16; ++i) v[i] = *(const f32x4*)(_s + (size_t)i * (t).N); } while (0)
__device__ __forceinline__ void cv_store(const f32x4 (&v)[16], const CvItem& t, LAS unsigned char* tile, int lane) {
    const int c = lane & 7, kg = lane >> 3;
#pragma unroll
    for (int j = 0; j < 4; ++j) { u32x4 w;
        w.x = pg8::pk4_fp8(v[0][j] * WSCALE, v[1][j] * WSCALE, v[2][j] * WSCALE, v[3][j] * WSCALE); w.y = pg8::pk4_fp8(v[4][j] * WSCALE, v[5][j] * WSCALE, v[6][j] * WSCALE, v[7][j] * WSCALE);
        w.z = pg8::pk4_fp8(v[8][j] * WSCALE, v[9][j] * WSCALE, v[10][j] * WSCALE, v[11][j] * WSCALE); w.w = pg8::pk4_fp8(v[12][j] * WSCALE, v[13][j] * WSCALE, v[14][j] * WSCALE, v[15][j] * WSCALE);
        *(LAS u32x4*)(tile + (4 * c + j) * 128 + ((kg ^ c) << 4)) = w; }
    LDS_WAIT(); asm volatile("" ::: "memory");
#pragma unroll
    for (int jj = 0; jj < 4; ++jj) { const int n = kg + 8 * jj;
        *(u32x4*)(t.dst + (size_t)n * D + 16 * c) = *(const LAS u32x4*)(tile + n * 128 + ((c ^ ((n >> 2) & 7)) << 4)); }
    LDS_WAIT(); asm volatile("" ::: "memory");
}
constexpr int SB = 32, SLOT_BYTES = 5 * SB * 256 + SB * 128, YB_OFF = 2 * SLOT_BYTES, YB_BYTES = SB * 128;
__device__ __forceinline__ float row8_sum(float x) { x = dpp_add<0xB1>(x); x = dpp_add<0x4E>(x); x = dpp_add<0x141>(x); return x; }
__device__ __forceinline__ void p4_scan(Frame& F) {
    bf16_t* Y = WSP(bf16_t, WS_Y);
    constexpr int NBLK = (TC + T) / SB;
    for (int task = F.bx; task < NB * NH * 2 * 2; task += F.G) {
        const int hf = (task >> 3) & 1, id_ = ((task >> 4) << 3) | (task & 7), d = id_ & 1, h = (id_ >> 1) & 15, b = id_ >> 5;
        __syncthreads();
        if (F.wave >= 4) {
            const int lt = F.tid - 256, lstep = lt >> 3, lpc = lt & 7;
            const bf16_t* Up = WSP(bf16_t, WS_SC) + (size_t)d * (SC_STRIDE / 2); const bf16_t* SBb = WSP(bf16_t, WS_SB);
            const bf16_t* arr[4] = { SBb + (size_t)SB_NKK * (SB_STRIDE / 2), SBb + (size_t)(SB_BB + d) * (SB_STRIDE / 2), SBb + (size_t)(SB_KD + d) * (SB_STRIDE / 2), SBb + (size_t)SB_R * (SB_STRIDE / 2) };
            const bf16_t* Vp = SBb + (size_t)SB_V * (SB_STRIDE / 2);
            struct Stage { u32x4 w; u32x4 o[4]; u32x4 v; };
            Stage sy;
#define P4_ISSUE(st, blk) do { const size_t ro = (size_t)scan_row((blk) * SB + lstep, b, d) * DR + h * 64; \
                st.w = *(const u32x4*)(Up + ro + lpc * 8); \
                _Pragma("unroll") for (int a = 0; a < 4; ++a) st.o[a] = *(const u32x4*)(arr[a] + ro + lpc * 8); \
                if (lpc < 4) st.v = *(const u32x4*)(Vp + ro + hf * 32 + lpc * 8); } while (0)
#define P4_CVTLO(u) ((f32x4){__builtin_bit_cast(float, (u).x << 16), __builtin_bit_cast(float, (u).x & 0xffff0000u), __builtin_bit_cast(float, (u).y << 16), __builtin_bit_cast(float, (u).y & 0xffff0000u)})
#define P4_CVTHI(u) ((f32x4){__builtin_bit_cast(float, (u).z << 16), __builtin_bit_cast(float, (u).z & 0xffff0000u), __builtin_bit_cast(float, (u).w << 16), __builtin_bit_cast(float, (u).w & 0xffff0000u)})
#define P4_COMMIT(st, slot) do { LAS unsigned char* sb_ = F.lds + (slot) * SLOT_BYTES + lstep * 256 + lpc * 32; \
                { const f32x4 u0_ = P4_CVTLO(st.w), u1_ = P4_CVTHI(st.w); *(LAS f32x4*)(sb_) = (f32x4){__expf(-u0_.x), __expf(-u0_.y), __expf(-u0_.z), __expf(-u0_.w)}; *(LAS f32x4*)(sb_ + 16) = (f32x4){__expf(-u1_.x), __expf(-u1_.y), __expf(-u1_.z), __expf(-u1_.w)}; } \
                _Pragma("unroll") for (int a = 0; a < 4; ++a) { *(LAS f32x4*)(sb_ + (a + 1) * (SB * 256)) = P4_CVTLO(st.o[a]); *(LAS f32x4*)(sb_ + (a + 1) * (SB * 256) + 16) = P4_CVTHI(st.o[a]); } \
                if (lpc < 4) { LAS unsigned char* vb_ = F.lds + (slot) * SLOT_BYTES + 5 * (SB * 256) + lstep * 128 + lpc * 32; *(LAS f32x4*)(vb_) = P4_CVTLO(st.v); *(LAS f32x4*)(vb_ + 16) = P4_CVTHI(st.v); } } while (0)
            P4_ISSUE(sy, 0); P4_COMMIT(sy, 0);
            P4_ISSUE(sy, 1);
            LAS unsigned char* cvtile = F.lds + YB_OFF + 2 * YB_BYTES + (F.wave - 4) * 4096;
            const int cvstride = F.G * 4; int cvit = (task == F.bx) ? F.bx * 4 + (F.wave - 4) : CV_ITEMS;
            f32x4 cvv[16]; CvItem cvt = cv_decode(F, cvit < CV_ITEMS ? cvit : 0); bool cvhave = cvit < CV_ITEMS;
            if (cvhave) CV_LOAD(cvv, cvt, F.lane);
            asm volatile("s_waitcnt lgkmcnt(0)" ::: "memory"); __builtin_amdgcn_s_barrier(); asm volatile("" ::: "memory");
            for (int blk = 0; blk < NBLK; ++blk) {
                if (blk + 1 < NBLK) P4_COMMIT(sy, (blk + 1) & 1);
                if (blk + 2 < NBLK) P4_ISSUE(sy, blk + 2);
                if (blk > 0 && (blk - 1) * SB >= TC) {
                    const LAS float* yb = (const LAS float*)(F.lds + YB_OFF + ((blk - 1) & 1) * YB_BYTES);
                    const int row = scan_row((blk - 1) * SB + lstep, b, d);
                    st_bf4(Y + (size_t)d * M_LAT * DR + (size_t)row * DR + h * 64 + hf * 32 + lpc * 4, *(const LAS f32x4*)(yb + lstep * 32 + lpc * 4));
                }
                if (cvhave) { cv_store(cvv, cvt, cvtile, F.lane); cvit += cvstride; cvhave = cvit < CV_ITEMS; if (cvhave) { cvt = cv_decode(F, cvit); CV_LOAD(cvv, cvt, F.lane); } }
                asm volatile("s_waitcnt lgkmcnt(0)" ::: "memory"); __builtin_amdgcn_s_barrier(); asm volatile("" ::: "memory");
            }
            while (cvhave) { cv_store(cvv, cvt, cvtile, F.lane); cvit += cvstride; cvhave = cvit < CV_ITEMS; if (cvhave) { cvt = cv_decode(F, cvit); CV_LOAD(cvv, cvt, F.lane); } }
            {   const LAS float* yb = (const LAS float*)(F.lds + YB_OFF + ((NBLK - 1) & 1) * YB_BYTES);
                const int row = scan_row((NBLK - 1) * SB + lstep, b, d);
                st_bf4(Y + (size_t)d * M_LAT * DR + (size_t)row * DR + h * 64 + hf * 32 + lpc * 4, *(const LAS f32x4*)(yb + lstep * 32 + lpc * 4)); }
#undef P4_ISSUE
#undef P4_COMMIT
#undef P4_CVTLO
#undef P4_CVTHI
        } else {
            const int rho = F.lane >> 3, kap = F.lane & 7, rloc = 8 * F.wave + rho;
            f32x2 s0 = {0.f, 0.f}, s1 = {0.f, 0.f}, s2 = {0.f, 0.f}, s3 = {0.f, 0.f};
            asm volatile("s_waitcnt lgkmcnt(0)" ::: "memory"); __builtin_amdgcn_s_barrier(); asm volatile("" ::: "memory");
            for (int blk = 0; blk < NBLK; ++blk) {
                const LAS unsigned char* sb = F.lds + (blk & 1) * SLOT_BYTES;
                LAS float* yb = (LAS float*)(F.lds + YB_OFF + (blk & 1) * YB_BYTES);
                const unsigned aK = (unsigned)(size_t)(sb) + kap * 32, aV = (unsigned)(size_t)(sb) + 5 * (SB * 256) + rloc * 4;
                f32x4 cw0, cw1, ca0, ca1, cb0, cb1, ck0, ck1, cr0, cr1; float cv;
#define P4_RDSET(P, base_, boff_, vbase_, voff_) do { P##w0 = lds_rd128<(boff_)>(base_); P##w1 = lds_rd128<(boff_) + 16>(base_); P##a0 = lds_rd128<(boff_) + SB * 256>(base_); P##a1 = lds_rd128<(boff_) + SB * 256 + 16>(base_); \
                    P##b0 = lds_rd128<(boff_) + 2 * SB * 256>(base_); P##b1 = lds_rd128<(boff_) + 2 * SB * 256 + 16>(base_); P##k0 = lds_rd128<(boff_) + 3 * SB * 256>(base_); P##k1 = lds_rd128<(boff_) + 3 * SB * 256 + 16>(base_); \
                    P##r0 = lds_rd128<(boff_) + 4 * SB * 256>(base_); P##r1 = lds_rd128<(boff_) + 4 * SB * 256 + 16>(base_); P##v = lds_rd32<(voff_)>(vbase_); } while (0)
#define P4_TIE(P) "+v"(P##w0), "+v"(P##w1), "+v"(P##a0), "+v"(P##a1), "+v"(P##b0), "+v"(P##b1), "+v"(P##k0), "+v"(P##k1), "+v"(P##r0), "+v"(P##r1), "+v"(P##v)
                P4_RDSET(c, aK, 0, aV, 0);
                asm volatile("s_waitcnt lgkmcnt(0)" : P4_TIE(c));
#pragma unroll 1
                for (int i0 = 0; i0 < SB; i0 += 8) {
                    float ykeep = 0.f; const unsigned aK0 = aK + i0 * 256, aV0 = aV + i0 * 128;
#define P4_STEP(II) do { f32x4 nw0, nw1, na0, na1, nb0, nb1, nk0, nk1, nr0, nr1; float nv; \
                        asm volatile("" : "+v"(s0)); \
                        P4_RDSET(n, aK0, ((II) + 1) * 256, aV0, ((II) + 1) * 128); \
                        f32x2 pp = pk_mul(s0, LO2(ca0)); pp = pk_fma(s1, HI2(ca0), pp); pp = pk_fma(s2, LO2(ca1), pp); pp = pk_fma(s3, HI2(ca1), pp); \
                        f32x2 cvp; cvp.x = cv; const f32x2 t0 = pk_mul_b0(cvp, LO2(ck0)), t1 = pk_mul_b0(cvp, HI2(ck0)), t2 = pk_mul_b0(cvp, LO2(ck1)), t3 = pk_mul_b0(cvp, HI2(ck1)); \
                        f32x2 sap; sap.x = row8_sum(add_(pp.x, pp.y)); \
                        s0 = pk_fma(s0, LO2(cw0), pk_fma_b0(sap, LO2(cb0), t0)); s1 = pk_fma(s1, HI2(cw0), pk_fma_b0(sap, HI2(cb0), t1)); \
                        s2 = pk_fma(s2, LO2(cw1), pk_fma_b0(sap, LO2(cb1), t2)); s3 = pk_fma(s3, HI2(cw1), pk_fma_b0(sap, HI2(cb1), t3)); \
                        f32x2 qq = pk_mul(s0, LO2(cr0)); qq = pk_fma(s1, HI2(cr0), qq); qq = pk_fma(s2, LO2(cr1), qq); qq = pk_fma(s3, HI2(cr1), qq); \
                        const float y = row8_sum(add_(qq.x, qq.y)); \
                        ykeep = (kap == (II)) ? y : ykeep; \
                        asm volatile("s_waitcnt lgkmcnt(0)" : P4_TIE(n), "+v"(s0)); \
                        cw0 = nw0; cw1 = nw1; ca0 = na0; ca1 = na1; cb0 = nb0; cb1 = nb1; ck0 = nk0; ck1 = nk1; cr0 = nr0; cr1 = nr1; cv = nv; } while (0)
                    P4_STEP(0); P4_STEP(1); P4_STEP(2); P4_STEP(3); P4_STEP(4); P4_STEP(5); P4_STEP(6); P4_STEP(7);
#undef P4_STEP
                    yb[(i0 + kap) * 32 + rloc] = ykeep;
                }
#undef P4_RDSET
#undef P4_TIE
                asm volatile("s_waitcnt lgkmcnt(0)" ::: "memory"); __builtin_amdgcn_s_barrier(); asm volatile("" ::: "memory");
            }
        }
        __syncthreads();
    }
}

__device__ __forceinline__ f32x4 row16_sum4(f32x4 v) { return (f32x4){row16_sum(v.x), row16_sum(v.y), row16_sum(v.z), row16_sum(v.w)}; }
__device__ __forceinline__ void p5_readout(Frame& F) {
    const bf16_t* SBb = WSP(bf16_t, WS_SB); const bf16_t* Y = WSP(bf16_t, WS_Y); const bf16_t* G = WSP(bf16_t, WS_G);
    const bf16_t* P = WSP(bf16_t, WS_P); bf16_t* MI = WSP(bf16_t, WS_MIXIN);
    const int t4 = F.lane >> 4, q = F.lane & 15;
    f32x4 rk[2], lw[2], lb[2];
#pragma unroll
    for (int hh = 0; hh < 2; ++hh) { const int c = (F.wave + 8 * hh) * 64 + 4 * q; rk[hh] = *(const f32x4*)(IN_RK + c); lw[hh] = *(const f32x4*)(IN_LNXW + c); lb[hh] = *(const f32x4*)(IN_LNXB + c); }
    const int cc = 128 * F.wave + 8 * q;
    f32x4 cw[3][2];
#pragma unroll
    for (int k = 0; k < 3; ++k) { cw[k][0] = *(const f32x4*)(IN_CONVW + k * DC + cc); cw[k][1] = *(const f32x4*)(IN_CONVW + k * DC + cc + 4); }
    for (int tg = F.bx; tg < M_LAT / 4; tg += F.G) {
        const int tok = 4 * tg + t4;
#pragma unroll
        for (int hh = 0; hh < 2; ++hh) {
            const int c = (F.wave + 8 * hh) * 64 + 4 * q; const size_t o = (size_t)tok * DR + c;
            const f32x4 r = ld_bf4(SBb + (size_t)SB_R * (SB_STRIDE / 2) + o), v = ld_bf4(SBb + (size_t)SB_V * (SB_STRIDE / 2) + o), g = ld_bf4(G + o);
            f32x4 osum = (f32x4){0.f, 0.f, 0.f, 0.f};
#pragma unroll
            for (int d = 0; d < 2; ++d) {
                const f32x4 y = ld_bf4(Y + (size_t)d * M_LAT * DR + o), kd = ld_bf4(SBb + (size_t)(SB_KD + d) * (SB_STRIDE / 2) + o);
                const float mu = row16_sum((y.x + y.y) + (y.z + y.w)) * (1.0f / 64.0f); const f32x4 dy = y - mu;
                const float var = row16_sum((dy.x * dy.x + dy.y * dy.y) + (dy.z * dy.z + dy.w * dy.w)) * (1.0f / 64.0f);
                const f32x4 rr = r * kd * rk[hh]; const float bonus = row16_sum((rr.x + rr.y) + (rr.z + rr.w));
                osum += dy * (1.0f / sqrtf(var + LNX_EPS)) * lw[hh] + lb[hh] + bonus * v;
            }
            st_bf4(MI + (size_t)tok * D + DC + c, osum * g);
        }
        {
            const int col = tok & 63; const bf16_t* pr = P + (size_t)tok * P_PAD + cc;
            f32x4 gb0, gb1, gc0, gc1, u0, u1, pg0, pg1, pu0, pu1, ng0, ng1, nu0, nu1; const f32x4 z = (f32x4){0.f, 0.f, 0.f, 0.f};
            ld_bf8(pr, gb0, gb1); ld_bf8(pr + DC, gc0, gc1); ld_bf8(pr + 2 * DC, u0, u1);
            if (col > 0) { ld_bf8(pr - P_PAD + DC, pg0, pg1); ld_bf8(pr - P_PAD + 2 * DC, pu0, pu1); } else { pg0 = z; pg1 = z; pu0 = z; pu1 = z; }
            if (col < 63) { ld_bf8(pr + P_PAD + DC, ng0, ng1); ld_bf8(pr + P_PAD + 2 * DC, nu0, nu1); } else { ng0 = z; ng1 = z; nu0 = z; nu1 = z; }
            const f32x4 o0 = gb0 * ((pg0 * pu0) * cw[0][0] + (gc0 * u0) * cw[1][0] + (ng0 * nu0) * cw[2][0]);
            const f32x4 o1 = gb1 * ((pg1 * pu1) * cw[0][1] + (gc1 * u1) * cw[1][1] + (ng1 * nu1) * cw[2][1]);
            u32x4 w; w.x = pg8::cvt_pk_bf16(o0.x, o0.y); w.y = pg8::cvt_pk_bf16(o0.z, o0.w); w.z = pg8::cvt_pk_bf16(o1.x, o1.y); w.w = pg8::cvt_pk_bf16(o1.z, o1.w);
            *(u32x4*)(MI + (size_t)tok * D + cc) = w;
        }
    }
}

__device__ __forceinline__ void p7_route(Frame& F, const bool do_route) {
    const float* mod = WSP(float, WS_MOD); const bf16_t* MIX = WSP(bf16_t, WS_MIX); bf16_t* X1 = WSP(bf16_t, WS_X1); unsigned char* H2 = WSP(unsigned char, WS_H2);
    int* tok_e = WSP(int, WS_ROUTE); int* tok_rank = tok_e + M_LAT * TOPK; float* tok_gate = (float*)(tok_rank + M_LAT * TOPK); int* elist = (int*)(tok_gate + M_LAT * TOPK);
    unsigned* cnt = WSP(unsigned, WS_CTL) + CW_CNT;
    const int gw = F.bx * NWAVES + F.wave, NGW = F.G * NWAVES, rep = F.bx % RR;
    LAS unsigned* lcnt = (LAS unsigned*)F.lds;
    LAS float* hbuf = (LAS float*)(F.lds + 1024);
    LAS float* part = (LAS float*)(F.lds + 1024 + 65536);
    LAS float* lgb = (LAS float*)(F.lds + 1024 + 65536 + 32768);
    __syncthreads();
    if (F.tid < 64) lcnt[F.tid] = 0u;
    __syncthreads();
    const int re = F.tid & 31;
    for (int row_ = gw; row_ < M_LAT + gw; row_ += NGW) {
        if (row_ - gw >= ((M_LAT + NGW - 1) / NGW) * NGW) break;
        const bool valid = row_ < M_LAT; const int row = valid ? row_ : M_LAT - 1;
        const float* mr = mod + (row / T) * NMOD;
        f32x4 v[8]; float ss = 0.f;
#pragma unroll
        for (int j = 0; j < 8; ++j) { v[j] = ld_bf4(MIX + (size_t)row * D + 4 * F.lane + 256 * j); ss += (v[j].x * v[j].x + v[j].y * v[j].y) + (v[j].z * v[j].z + v[j].w * v[j].w); }
        float rstd = 1.0f / sqrtf(wave_sum(ss) * (1.0f / D) + RMS_EPS);
        ss = 0.f;
#pragma unroll
        for (int j = 0; j < 8; ++j) { const int c = 4 * F.lane + 256 * j;
            const f32x4 xv = *(const f32x4*)(IN_X + (size_t)row * D + c), g = *(const f32x4*)(IN_NORMG + D + c), gt = *(const f32x4*)(mr + 2 * D + c);
            v[j] = xv + gt * (v[j] * rstd * g);
            if (valid) st_bf4(X1 + (size_t)row * D + c, v[j]);
            ss += (v[j].x * v[j].x + v[j].y * v[j].y) + (v[j].z * v[j].z + v[j].w * v[j].w); }
        rstd = 1.0f / sqrtf(wave_sum(ss) * (1.0f / D) + RMS_EPS);
#pragma unroll
        for (int j = 0; j < 8; ++j) { const int c = 4 * F.lane + 256 * j;
            const f32x4 g = *(const f32x4*)(IN_NORMG + 2 * D + c), sh = *(const f32x4*)(mr + 3 * D + c), sc = *(const f32x4*)(mr + 4 * D + c);
            const f32x4 hv = (v[j] * rstd * g) * (sc + 1.0f) + sh;
            if (valid) *(unsigned*)(H2 + (size_t)row * D + c) = pg8::pk4_fp8(hv.x, hv.y, hv.z, hv.w);
            *(LAS f32x4*)(hbuf + F.wave * D + c) = hv; }
        __syncthreads();
        {
            f32x4 acc[8];
#pragma unroll
            for (int r = 0; r < 8; ++r) acc[r] = (f32x4){0.f, 0.f, 0.f, 0.f};
            const int cg = F.lane >> 3, eq = F.lane & 7;
            const float* wp = IN_WROUTER + (size_t)(256 * F.wave + cg) * NE + 4 * eq;
            const LAS float* hp = hbuf + 256 * F.wave + cg;
#pragma unroll 8
            for (int it = 0; it < 32; ++it) { const f32x4 w4 = *(const f32x4*)(wp + (size_t)(8 * it) * NE);
#pragma unroll
                for (int r = 0; r < 8; ++r) acc[r] += hp[r * D + 8 * it] * w4; }
#pragma unroll
            for (int r = 0; r < 8; ++r) { acc[r].x = dpp_add<0x128>(acc[r].x); acc[r].y = dpp_add<0x128>(acc[r].y); acc[r].z = dpp_add<0x128>(acc[r].z); acc[r].w = dpp_add<0x128>(acc[r].w); }
            if (!(cg & 1)) {
#pragma unroll
                for (int r = 0; r < 8; ++r) *(LAS f32x4*)(part + ((F.wave * 4 + (cg >> 1)) * 8 + r) * 32 + 4 * eq) = acc[r]; }
        }
        __syncthreads();
        if (F.tid < 256) { const int r = F.tid >> 5; float s = IN_BROUTER[re];
#pragma unroll 16
            for (int j = 0; j < 32; ++j) s += part[(j * 8 + r) * 32 + re];
            lgb[r * 32 + re] = s; }
        __syncthreads();
        float lg[NE];
#pragma unroll
        for (int e4 = 0; e4 < NE / 4; ++e4) { const f32x4 t = *(const LAS f32x4*)(lgb + F.wave * 32 + 4 * e4); lg[4 * e4] = t.x; lg[4 * e4 + 1] = t.y; lg[4 * e4 + 2] = t.z; lg[4 * e4 + 3] = t.w; }
        unsigned taken = 0u; int es[TOPK]; float vs[TOPK];
#pragma unroll
        for (int k = 0; k < TOPK; ++k) { float best = -3.0e38f; int bi = 0;
#pragma unroll
            for (int e = 0; e < NE; ++e) { const bool ok = !((taken >> e) & 1u) && lg[e] > best; best = ok ? lg[e] : best; bi = ok ? e : bi; }
            taken |= 1u << bi; es[k] = bi; vs[k] = best; }
        float ps[TOPK], psum = 0.f;
#pragma unroll
        for (int k = 0; k < TOPK; ++k) { ps[k] = __expf(vs[k] - vs[0]); psum += ps[k]; }
        if (do_route && valid && F.lane < TOPK) {
            const int k = F.lane; const int e = k == 0 ? es[0] : k == 1 ? es[1] : k == 2 ? es[2] : es[3]; const float p = k == 0 ? ps[0] : k == 1 ? ps[1] : k == 2 ? ps[2] : ps[3];
            const int lr = (int)__hip_atomic_fetch_add(lcnt + e, 1u, __ATOMIC_RELAXED, __HIP_MEMORY_SCOPE_WORKGROUP);
            tok_e[row * TOPK + k] = e; tok_rank[row * TOPK + k] = lr; tok_gate[row * TOPK + k] = p / psum;
        }
    }
    if (!do_route) return;
    __syncthreads();
    if (F.tid < NE) { const unsigned c = lcnt[F.tid]; lcnt[32 + F.tid] = c ? atomicAdd(cnt + (rep * NE + F.tid) * 16, c) : 0u; }
    __syncthreads();
    for (int row = gw; row < M_LAT; row += NGW)
        if (F.lane < TOPK) { const int e = tok_e[row * TOPK + F.lane]; const int idx = (int)lcnt[32 + e] + tok_rank[row * TOPK + F.lane];
            tok_rank[row * TOPK + F.lane] = idx; elist[((size_t)e * RR + rep) * RCAP + idx] = row; }
}

__device__ __forceinline__ void p11_final(Frame& F) {
    build_tab(F);
    const LAS int* tab = (const LAS int*)(F.lds + TAB_OFF); const LAS int* rp = (const LAS int*)(F.lds + RP_OFF);
    const float* mod = WSP(float, WS_MOD); const bf16_t* X1 = WSP(bf16_t, WS_X1); const bf16_t* YM = WSP(bf16_t, WS_YM);
    const int* tok_e = WSP(int, WS_ROUTE); const int* tok_rank = tok_e + M_LAT * TOPK; const float* tok_gate = (const float*)(tok_rank + M_LAT * TOPK);
    const int gw = F.bx * NWAVES + F.wave, NGW = F.G * NWAVES;
    for (int row = gw; row < M_LAT; row += NGW) {
        const float* mr = mod + (row / T) * NMOD;
        f32x4 v[8];
#pragma unroll
        for (int j = 0; j < 8; ++j) v[j] = (f32x4){0.f, 0.f, 0.f, 0.f};
#pragma unroll
        for (int k = 0; k < TOPK; ++k) {
            const int e = tok_e[row * TOPK + k], rank = tok_rank[row * TOPK + k]; const float gt = tok_gate[row * TOPK + k];
            const bf16_t* yr = YM + (size_t)(tab[e] + rp[e * RR + ((row % NGW) / NWAVES) % RR] + rank) * D;
#pragma unroll
            for (int j = 0; j < 8; ++j) { const u32x2 w = *(const u32x2*)(yr + 4 * F.lane + 256 * j);
                v[j].x += gt * __builtin_bit_cast(float, w.x << 16); v[j].y += gt * __builtin_bit_cast(float, w.x & 0xffff0000u);
                v[j].z += gt * __builtin_bit_cast(float, w.y << 16); v[j].w += gt * __builtin_bit_cast(float, w.y & 0xffff0000u); }
        }
        float ss = 0.f;
#pragma unroll
        for (int j = 0; j < 8; ++j) ss += (v[j].x * v[j].x + v[j].y * v[j].y) + (v[j].z * v[j].z + v[j].w * v[j].w);
        const float rstd = 1.0f / sqrtf(wave_sum(ss) * (1.0f / D) + RMS_EPS);
#pragma unroll
        for (int j = 0; j < 8; ++j) { const int c = 4 * F.lane + 256 * j;
            const f32x4 xv = ld_bf4(X1 + (size_t)row * D + c), g = *(const f32x4*)(IN_NORMG + 3 * D + c), gt = *(const f32x4*)(mr + 5 * D + c);
            *(f32x4*)(F.out + (size_t)row * D + c) = xv + gt * (v[j] * rstd * g); }
    }
}

#ifndef MK_N_LAUNCHES
#define MK_N_LAUNCHES 1
#endif
constexpr int N_PHASES = 12;
struct Args { const float* in[27]; float* out; unsigned char* ws; int ph_lo, ph_hi; };
__global__ void __launch_bounds__(NTHR, 2) fwd_kernel(Args args) {
    extern __shared__ __attribute__((aligned(16))) unsigned char lds_raw[];
    Frame F;
    F.lds = (LAS unsigned char*)lds_raw;
    F.tid = threadIdx.x; F.lane = F.tid & 63; F.wave = __builtin_amdgcn_readfirstlane(F.tid >> 6);
    F.G = gridDim.x; F.bx = blockIdx.x;
#pragma unroll
    for (int i = 0; i < 27; ++i) F.in[i] = args.in[i];
    F.out = args.out; F.ws = args.ws;
    volatile LAS unsigned* MISC = (volatile LAS unsigned*)(F.lds + MISC_OFF);
    if (F.tid < 64) MISC[F.tid] = 0u;
    __syncthreads();
    XcdBarrier bar; bar.bar = WSP(unsigned, WS_CTL) + CW_BAR; bar.x = 0; bar.st = nullptr;
    if (MK_N_LAUNCHES == 1) bar = xcd_barrier_post(WSP(unsigned, WS_CTL) + CW_BAR, MISC + 8);
    const int lo = args.ph_lo, hi = args.ph_hi;
#define IN(k) (lo <= (k) && (k) < hi)
#define SEAM(k) do { if (IN(k) && IN((k) + 1)) xcd_barrier(bar); } while (0)

    if (IN(0)) { p0_prologue(F); SEAM(0); }
    if (IN(1)) { p1_norm(F); SEAM(1); }
    if (IN(2)) {
        const int n = build_list(F, 0);
        pg8::Gemm g{WSP(bf16_t, WS_H), WSP(bf16_t, WS_WIN), 2 * D}; pg8::ListOrder S{(const LAS int*)(F.lds + LIST_OFF), n};
        pg8::EpiBf16S E{WSP(bf16_t, WS_P), P_PAD, nullptr, 1 << 20, 0, 1.0f, F.lds + STG_OFF};
        pg8::gemm_phase<pg8::EpiBf16S, pg8::ListOrder, true, false>(F.lds, g, S, E);
        SEAM(2);
    }
    if (IN(3)) { p3_inputs(F); SEAM(3); }
    if (IN(4)) { p4_scan(F); SEAM(4); }
    if (IN(5)) { p5_readout(F); SEAM(5); }
    if (IN(6)) {
        const int n = build_list(F, 1);
        pg8::Gemm g{WSP(bf16_t, WS_MIXIN), WSP(bf16_t, WS_WOUT), 2 * D}; pg8::ListOrder S{(const LAS int*)(F.lds + LIST_OFF), n};
        pg8::EpiBf16S E{WSP(bf16_t, WS_MIX), D, nullptr, 1 << 20, 0, 1.0f, F.lds + STG_OFF};
        pg8::gemm_phase<pg8::EpiBf16S, pg8::ListOrder, true, false>(F.lds, g, S, E);
        SEAM(6);
    }
    if (IN(7)) { p7_route(F, true); if (IN(7) && IN(9)) xcd_barrier(bar); }
    if (IN(9)) {
        build_tab(F); const int n = build_list(F, 2);
        pg8::Gemm g{WSP(unsigned char, WS_H2), WSP(unsigned char, WS_WGU), D};
        const pg8::GatherInfo GI{WSP(int, WS_ROUTE) + 3 * M_LAT * TOPK, (const LAS int*)(F.lds + TAB_OFF), (const LAS int*)(F.lds + RP_OFF), 16, RR, RCAP}; pg8::ListOrder S{(const LAS int*)(F.lds + LIST_OFF), n};
        pg8::EpiSwigluS E{WSP(unsigned char, WS_ACT), DE, IN_BGU, 16, 2 * DE, 1.0f / WSCALE, F.lds + STG_OFF};
        pg8::gemm_phase<pg8::EpiSwigluS, pg8::ListOrder, true, true, true>(F.lds, g, S, E, GI);
        SEAM(9);
    }
    if (IN(10)) {
        build_tab(F); const int n = build_list(F, 3);
        pg8::Gemm g{WSP(unsigned char, WS_ACT), WSP(unsigned char, WS_WDN), DE}; pg8::ListOrder S{(const LAS int*)(F.lds + LIST_OFF), n};
        pg8::EpiBf16S E{WSP(bf16_t, WS_YM), D, IN_BDN, 8, D, 1.0f / WSCALE, F.lds + STG_OFF};
        pg8::gemm_phase<pg8::EpiBf16S, pg8::ListOrder, true, true>(F.lds, g, S, E);
        SEAM(10);
    }
    if (IN(11)) { p11_final(F); }
#undef IN
#undef SEAM
}

extern "C" void kernel_launch(void* const* d_in, const int* in_sizes, int n_in, void* d_out, int out_size, void* d_ws, size_t ws_size, hipStream_t stream) {
    static int grid = 0;
    if (grid == 0) {
        if (n_in != 27 || out_size != M_LAT * D || ws_size < WS_END) { fprintf(stderr, "kernel_launch: bad shapes (n_in %d, out %d, ws %zu < %zu); nothing launched\n", n_in, out_size, ws_size, (size_t)WS_END); grid = -1; return; }
        int dev = 0, cus = 0, per_cu = 0;
        if (hipGetDevice(&dev) != hipSuccess || hipDeviceGetAttribute(&cus, hipDeviceAttributeMultiprocessorCount, dev) != hipSuccess) { grid = -1; return; }
        if (hipFuncSetAttribute((const void*)fwd_kernel, hipFuncAttributeMaxDynamicSharedMemorySize, LDS_BYTES) != hipSuccess) { fprintf(stderr, "kernel_launch: hipFuncSetAttribute failed\n"); grid = -1; return; }
        if (hipOccupancyMaxActiveBlocksPerMultiprocessor(&per_cu, (const void*)fwd_kernel, NTHR, LDS_BYTES) != hipSuccess || per_cu < 1) fprintf(stderr, "kernel_launch: occupancy query reports %d\n", per_cu);
        (void)hipGetLastError();
        grid = cus;
    }
    if (grid < 0) return;
    if (hipMemsetAsync((char*)d_ws + WS_CTL, 0, CTL_ZERO_BYTES, stream) != hipSuccess) return;
    Args a{};
    for (int i = 0; i < 27; ++i) a.in[i] = (const float*)d_in[i];
    a.out = (float*)d_out; a.ws = (unsigned char*)d_ws;
    if (MK_N_LAUNCHES == 1) { a.ph_lo = 0; a.ph_hi = N_PHASES; hipLaunchKernelGGL(fwd_kernel, dim3(grid), dim3(NTHR), LDS_BYTES, stream, a); }
    if (MK_N_LAUNCHES != 1) for (int p = 0; p < N_PHASES; ++p) { a.ph_lo = p; a.ph_hi = p + 1; hipLaunchKernelGGL(fwd_kernel, dim3(grid), dim3(NTHR), LDS_BYTES, stream, a); }
}
```

```cpp
#include <hip/hip_runtime.h>
#include <cstdio>
#include <cstdint>

#define GAS __attribute__((address_space(1)))
#define LAS __attribute__((address_space(3)))
typedef unsigned short bf16_t;
typedef short bf16x8 __attribute__((ext_vector_type(8)));
typedef float f32x4 __attribute__((ext_vector_type(4)));
typedef float f32x2 __attribute__((ext_vector_type(2)));
typedef unsigned u32x4 __attribute__((ext_vector_type(4)));
typedef unsigned u32x2 __attribute__((ext_vector_type(2)));
typedef int i32x4 __attribute__((ext_vector_type(4)));
typedef int i32x8 __attribute__((ext_vector_type(8)));

namespace pg8 {
constexpr int BM = 256, BK = 64, HALF = 128, HTB = HALF * BK * 2, STAGE_BYTES = 8 * HTB, NXCD = 8, WGM = 8;
__host__ __device__ __forceinline__ int lds_byte(int r, int c) { const int st = (r >> 4) * 2 + (c >> 5), rr = r & 15, cc = c & 31, ob = rr * 64 + cc * 2; return st * 1024 + (ob ^ (((ob >> 9) & 1) << 5)); }
__host__ __device__ __forceinline__ void stage_rc(int b, int& R, int& C) { const int st = b / 1024, sb = b % 1024, swz = sb ^ (((sb >> 9) & 1) << 5); R = (st >> 1) * 16 + swz / 64; C = (st & 1) * 32 + (swz % 64) / 2; }
__host__ __device__ __forceinline__ int perm32(int rho) { const int n = rho >> 4, i = rho & 15; return 8 * (i >> 2) + 4 * n + (i & 3); }

struct Unit { int pm, pn; };
struct Gemm { const void* A; const void* Bt; int rowbytes; };

__device__ __forceinline__ unsigned cvt_pk_bf16(float lo, float hi) { unsigned r; asm volatile("v_cvt_pk_bf16_f32 %0, %1, %2" : "=v"(r) : "v"(lo), "v"(hi)); return r; }

struct ListOrder {
    const LAS int* list; int n;
    __device__ __forceinline__ bool next(int i, Unit& u) const { if (i >= n) return false; u.pm = list[2 * i]; u.pn = list[2 * i + 1]; return true; }
    __device__ __forceinline__ void a_ready(const Unit&) const {}
    __device__ __forceinline__ void done(const Unit&) const {}
};

struct EpiF32 {
    static constexpr bool PERM = false;
    float* C; int ldc;
    __device__ __forceinline__ void operator()(const f32x4 (&acc)[2][2][4][2], const Unit& u, int wr, int wc, int fr, int fq) const {
        const int row0 = u.pm * BM + wr * 64 + fr, col0 = u.pn * BM + wc * 32 + 4 * fq;
#pragma unroll
        for (int ai = 0; ai < 2; ++ai)
#pragma unroll
            for (int m = 0; m < 4; ++m) { float* rowp = C + (size_t)(row0 + ai * HALF + m * 16) * ldc + col0;
#pragma unroll
                for (int bj = 0; bj < 2; ++bj)
#pragma unroll
                    for (int n = 0; n < 2; ++n) *(f32x4*)(rowp + bj * HALF + n * 16) = acc[ai][bj][m][n]; }
    }
};
struct EpiBf16 {
    static constexpr bool PERM = true;
    bf16_t* O; int ldc; const float* bias; int npn; int bias_ld; float scale;
    __device__ __forceinline__ void operator()(const f32x4 (&acc)[2][2][4][2], const Unit& u, int wr, int wc, int fr, int fq) const {
        const int e = u.pn / npn, pnl = u.pn - e * npn;
        const int row0 = u.pm * BM + wr * 64 + fr; const int col0 = pnl * BM + wc * 32 + 8 * fq;
        f32x4 bv[2][2];
#pragma unroll
        for (int bj = 0; bj < 2; ++bj)
#pragma unroll
            for (int n = 0; n < 2; ++n) bv[bj][n] = bias ? *(const f32x4*)(bias + (size_t)e * bias_ld + col0 + bj * HALF + 4 * n) : (f32x4){0.f, 0.f, 0.f, 0.f};
#pragma unroll
        for (int ai = 0; ai < 2; ++ai)
#pragma unroll
            for (int m = 0; m < 4; ++m) { bf16_t* rowp = O + (size_t)(row0 + ai * HALF + m * 16) * ldc + col0;
#pragma unroll
                for (int bj = 0; bj < 2; ++bj) { const f32x4 v0 = acc[ai][bj][m][0] * scale + bv[bj][0], v1 = acc[ai][bj][m][1] * scale + bv[bj][1];
                    u32x4 w; w.x = cvt_pk_bf16(v0[0], v0[1]); w.y = cvt_pk_bf16(v0[2], v0[3]); w.z = cvt_pk_bf16(v1[0], v1[1]); w.w = cvt_pk_bf16(v1[2], v1[3]);
                    *(u32x4*)(rowp + bj * HALF) = w; } }
    }
};
struct EpiNone { static constexpr bool PERM = true; float* sink;
    __device__ __forceinline__ void operator()(const f32x4 (&acc)[2][2][4][2], const Unit& u, int wr, int wc, int fr, int fq) const {
        float t = 0.f;
#pragma unroll
        for (int ai = 0; ai < 2; ++ai)
#pragma unroll
            for (int bj = 0; bj < 2; ++bj)
#pragma unroll
                for (int m = 0; m < 4; ++m)
#pragma unroll
                    for (int n = 0; n < 2; ++n) t += acc[ai][bj][m][n][0];
        if (t == 123456.789f) *sink = t; } };
__device__ __forceinline__ float swiglu1(float g, float l) {
    g = fminf(g, 7.0f); l = fminf(fmaxf(l, -7.0f), 7.0f);
    const float s = __builtin_amdgcn_rcpf(1.0f + __expf(-1.702f * g));
    return g * s * (l + 1.0f);
}
__device__ __forceinline__ unsigned pk4_fp8(float a, float b, float c, float d) { int w = 0; w = __builtin_amdgcn_cvt_pk_fp8_f32(a, b, w, false); w = __builtin_amdgcn_cvt_pk_fp8_f32(c, d, w, true); return (unsigned)w; }
struct EpiSwiglu {
    static constexpr bool PERM = true;
    unsigned char* O; int ldc; const float* bias; int npn; int bias_ld; float scale;
    __device__ __forceinline__ void operator()(const f32x4 (&acc)[2][2][4][2], const Unit& u, int wr, int wc, int fr, int fq) const {
        const int e = u.pn / npn, pnl = u.pn - e * npn;
        const int row0 = u.pm * BM + wr * 64 + fr; const int col0 = pnl * BM + wc * 32 + 8 * fq;
        f32x4 bv[2][2];
#pragma unroll
        for (int bj = 0; bj < 2; ++bj)
#pragma unroll
            for (int n = 0; n < 2; ++n) bv[bj][n] = *(const f32x4*)(bias + (size_t)e * bias_ld + col0 + bj * HALF + 4 * n);
#pragma unroll
        for (int ai = 0; ai < 2; ++ai)
#pragma unroll
            for (int m = 0; m < 4; ++m) { unsigned char* rowp = O + (size_t)(row0 + ai * HALF + m * 16) * ldc + (col0 >> 1);
#pragma unroll
                for (int bj = 0; bj < 2; ++bj) { const f32x4 v0 = acc[ai][bj][m][0] * scale + bv[bj][0], v1 = acc[ai][bj][m][1] * scale + bv[bj][1];
                    *(unsigned*)(rowp + bj * (HALF / 2)) = pk4_fp8(swiglu1(v0[0], v0[1]), swiglu1(v0[2], v0[3]), swiglu1(v1[0], v1[1]), swiglu1(v1[2], v1[3])); } }
    }
};

constexpr int STG_PITCH = 528, STG8_PITCH = 144;
struct EpiBf16S {
    static constexpr bool PERM = true;
    bf16_t* O; int ldc; const float* bias; int npn; int bias_ld; float scale; LAS unsigned char* stg; LAS unsigned char* stg2;
    __device__ __forceinline__ void operator()(const f32x4 (&acc)[2][2][4][2], const Unit& u, int wr, int wc, int fr, int fq) const {
        const int e = u.pn / npn, pnl = u.pn - e * npn; const int tid = threadIdx.x;
        const int col0 = pnl * BM + wc * 32 + 8 * fq;
        f32x4 bv[2][2];
#pragma unroll
        for (int bj = 0; bj < 2; ++bj)
#pragma unroll
            for (int n = 0; n < 2; ++n) bv[bj][n] = bias ? *(const f32x4*)(bias + (size_t)e * bias_ld + col0 + bj * HALF + 4 * n) : (f32x4){0.f, 0.f, 0.f, 0.f};
        LAS unsigned char* wp0 = stg + (16 * wr + fr) * STG_PITCH + 64 * wc + 16 * fq;
        LAS unsigned char* wp1 = stg2 + (16 * wr + fr) * 512 + (((4 * wc + fq) ^ (fr & 7)) * 16);
        const int rr = tid >> 4, cc = tid & 15; const LAS unsigned char* rp0 = stg + rr * STG_PITCH + cc * 16;
        const LAS unsigned char* rp1 = stg2 + rr * 512 + ((cc ^ (rr & 7)) * 16);
        bf16_t* gp = O + (size_t)(u.pm * BM + 64 * (rr >> 4) + (rr & 15)) * ldc + pnl * BM + cc * 8;
#pragma unroll
        for (int ai = 0; ai < 2; ++ai)
#pragma unroll
            for (int mp = 0; mp < 2; ++mp) {
#pragma unroll
                for (int s = 0; s < 2; ++s)
#pragma unroll
                    for (int bj = 0; bj < 2; ++bj) { const int m = 2 * mp + s; const f32x4 v0 = acc[ai][bj][m][0] * scale + bv[bj][0], v1 = acc[ai][bj][m][1] * scale + bv[bj][1];
                        u32x4 w; w.x = cvt_pk_bf16(v0[0], v0[1]); w.y = cvt_pk_bf16(v0[2], v0[3]); w.z = cvt_pk_bf16(v1[0], v1[1]); w.w = cvt_pk_bf16(v1[2], v1[3]);
                        *(LAS u32x4*)((s ? wp1 : wp0) + 256 * bj) = w; }
                asm volatile("s_waitcnt lgkmcnt(0)" ::: "memory"); __builtin_amdgcn_s_barrier(); asm volatile("" ::: "memory");
                bf16_t* g2 = gp + (size_t)(ai * HALF + mp * 32) * ldc;
                *(u32x4*)(g2) = *(const LAS u32x4*)(rp0); *(u32x4*)(g2 + HALF) = *(const LAS u32x4*)(rp0 + 256);
                *(u32x4*)(g2 + (size_t)16 * ldc) = *(const LAS u32x4*)(rp1); *(u32x4*)(g2 + (size_t)16 * ldc + HALF) = *(const LAS u32x4*)(rp1 + 256);
                asm volatile("s_waitcnt lgkmcnt(0)" ::: "memory"); __builtin_amdgcn_s_barrier(); asm volatile("" ::: "memory");
            }
    }
};
struct EpiF8S {
    static constexpr bool PERM = true;
    unsigned char* O; int ldc; const float* bias; int npn; int bias_ld; float scale; LAS unsigned char* stg;
    __device__ __forceinline__ void operator()(const f32x4 (&acc)[2][2][4][2], const Unit& u, int wr, int wc, int fr, int fq) const {
        const int e = u.pn / npn, pnl = u.pn - e * npn; const int tid = threadIdx.x;
        const int col0 = pnl * BM + wc * 32 + 8 * fq;
        f32x4 bv[2][2];
#pragma unroll
        for (int bj = 0; bj < 2; ++bj)
#pragma unroll
            for (int n = 0; n < 2; ++n) bv[bj][n] = *(const f32x4*)(bias + (size_t)e * bias_ld + col0 + bj * HALF + 4 * n);
        constexpr int PITCH = 272, SLAB = 32 * PITCH;
        LAS unsigned char* wp = stg + (16 * wr + fr) * PITCH + 32 * wc + 8 * fq;
        const int rr = tid >> 4, cc = tid & 15; const LAS unsigned char* rp = stg + rr * PITCH + cc * 16;
        unsigned char* gp = O + (size_t)(u.pm * BM + 64 * (rr >> 4) + (rr & 15)) * ldc + pnl * BM + cc * 16;
#pragma unroll
        for (int ai = 0; ai < 2; ++ai)
#pragma unroll
            for (int mp = 0; mp < 2; ++mp) {
#pragma unroll
                for (int ms = 0; ms < 2; ++ms)
#pragma unroll
                    for (int bj = 0; bj < 2; ++bj) { const int m = 2 * mp + ms; const f32x4 v0 = acc[ai][bj][m][0] * scale + bv[bj][0], v1 = acc[ai][bj][m][1] * scale + bv[bj][1];
                        u32x2 w; w.x = pk4_fp8(v0[0], v0[1], v0[2], v0[3]); w.y = pk4_fp8(v1[0], v1[1], v1[2], v1[3]);
                        *(LAS u32x2*)(wp + ms * SLAB + 128 * bj) = w; }
                asm volatile("s_waitcnt lgkmcnt(0)" ::: "memory"); __builtin_amdgcn_s_barrier(); asm volatile("" ::: "memory");
#pragma unroll
                for (int ms = 0; ms < 2; ++ms) *(u32x4*)(gp + (size_t)(ai * HALF + (2 * mp + ms) * 16) * ldc) = *(const LAS u32x4*)(rp + ms * SLAB);
                asm volatile("s_waitcnt lgkmcnt(0)" ::: "memory"); __builtin_amdgcn_s_barrier(); asm volatile("" ::: "memory");
            }
    }
};
struct EpiSwigluS {
    static constexpr bool PERM = true;
    unsigned char* O; int ldc; const float* bias; int npn; int bias_ld; float scale; LAS unsigned char* stg;
    __device__ __forceinline__ void operator()(const f32x4 (&acc)[2][2][4][2], const Unit& u, int wr, int wc, int fr, int fq) const {
        const int e = u.pn / npn, pnl = u.pn - e * npn; const int tid = threadIdx.x;
        const int col0 = pnl * BM + wc * 32 + 8 * fq;
        f32x4 bv[2][2];
#pragma unroll
        for (int bj = 0; bj < 2; ++bj)
#pragma unroll
            for (int n = 0; n < 2; ++n) bv[bj][n] = *(const f32x4*)(bias + (size_t)e * bias_ld + col0 + bj * HALF + 4 * n);
        LAS unsigned char* wp = stg + (16 * wr + fr) * STG8_PITCH + 16 * wc + 4 * fq;
        const int rr = (tid >> 3) & 31, cc = tid & 7, ms = tid >> 8;
        const LAS unsigned char* rp = stg + rr * STG8_PITCH + cc * 16;
        unsigned char* gp = O + (size_t)(u.pm * BM + 64 * (rr >> 4) + (rr & 15)) * ldc + pnl * (BM / 2) + cc * 16;
#pragma unroll
        for (int ai = 0; ai < 2; ++ai) {
#pragma unroll
            for (int m = 0; m < 4; ++m)
#pragma unroll
                for (int bj = 0; bj < 2; ++bj) { const f32x4 v0 = acc[ai][bj][m][0] * scale + bv[bj][0], v1 = acc[ai][bj][m][1] * scale + bv[bj][1];
                    *(LAS unsigned*)(wp + m * (32 * STG8_PITCH) + 64 * bj) = pk4_fp8(swiglu1(v0[0], v0[1]), swiglu1(v0[2], v0[3]), swiglu1(v1[0], v1[1]), swiglu1(v1[2], v1[3])); }
            asm volatile("s_waitcnt lgkmcnt(0)" ::: "memory"); __builtin_amdgcn_s_barrier(); asm volatile("" ::: "memory");
#pragma unroll
            for (int k2 = 0; k2 < 2; ++k2) { const int m = ms + 2 * k2;
                *(u32x4*)(gp + (size_t)(ai * HALF + m * 16) * ldc) = *(const LAS u32x4*)(rp + m * (32 * STG8_PITCH)); }
            asm volatile("s_waitcnt lgkmcnt(0)" ::: "memory"); __builtin_amdgcn_s_barrier(); asm volatile("" ::: "memory");
        }
    }
};

struct GatherInfo { const int* elist; const LAS int* tab; const LAS int* rp; int npn; int nrep; int rcap; };
template <class Epi, class Sched, bool ALIGN_EPI, bool FP8, bool GATHER = false>
__device__ __forceinline__ void gemm_phase(LAS unsigned char* lds, const Gemm g, const Sched& S, const Epi& E, const GatherInfo GI = GatherInfo{nullptr, nullptr, nullptr, 1, 1, 0}) {
    const int tid = threadIdx.x, wid = __builtin_amdgcn_readfirstlane(tid >> 6), lane = tid & 63, wr = wid >> 2, wc = wid & 3, fr = lane & 15, fq = lane >> 4;
    const int RB = g.rowbytes, nt = RB / 128;
    unsigned voffA[2], voffB[2]; int rowA[2], colA2[2];
#pragma unroll
    for (int i = 0; i < 2; ++i) { int R, C; stage_rc(tid * 16 + i * 8192, R, C); const int Rb = Epi::PERM ? ((R & ~31) + perm32(R & 31)) : R;
        voffA[i] = (unsigned)(R * RB + C * 2); voffB[i] = (unsigned)(Rb * RB + C * 2); rowA[i] = R; colA2[i] = C * 2; }
    unsigned gc[2][2], gn[2][2];
#define PG8_GOFF(u_, go_) do { const int e_ = (u_).pn / GI.npn; const int base_ = (u_).pm * BM - GI.tab[e_]; const int cnt_ = GI.tab[64 + e_]; const LAS int* rp_ = GI.rp + e_ * GI.nrep; \
        _Pragma("unroll") for (int h_ = 0; h_ < 2; ++h_) _Pragma("unroll") for (int i_ = 0; i_ < 2; ++i_) { const int ii_ = base_ + 128 * h_ + rowA[i_]; int r_ = 0; \
            for (int j_ = 1; j_ < GI.nrep; ++j_) r_ += (rp_[j_] <= ii_) ? 1 : 0; \
            const int tok_ = ii_ < cnt_ ? GI.elist[((size_t)e_ * GI.nrep + r_) * GI.rcap + (ii_ - rp_[r_])] : 0; go_[h_][i_] = (unsigned)tok_ * (unsigned)RB + (unsigned)colA2[i_]; } } while (0)
#define PG8_STAGE_G(bufoff, go_, kb_) do { _Pragma("unroll") for (int _i = 0; _i < 2; ++_i) \
        __builtin_amdgcn_global_load_lds((const unsigned*)((const char*)g.A + (go_)[_i] + (kb_)), (LAS unsigned*)(lds + (bufoff) + ldsw + _i * 8192), 16, 0, 0); } while (0)
#define PG8_STAGE_A(bufoff, ptr_, h_, usenext_, kb_) do { if constexpr (GATHER) { unsigned o_[2] = { (usenext_) ? gn[h_][0] : gc[h_][0], (usenext_) ? gn[h_][1] : gc[h_][1] }; PG8_STAGE_G(bufoff, o_, kb_); } else { PG8_STAGE(bufoff, ptr_, voffA); } } while (0)
    const size_t kstep = 128;
    const size_t hstep = (size_t)HALF * RB;
    const size_t tstep = 2 * hstep;
    const unsigned ldsw = (unsigned)wid * 1024u;
    const int aoff = lds_byte(wr * 64 + fr, fq * 8), boff = lds_byte(wc * 32 + fr, fq * 8);
#define PG8_SA(b, h) (((b) * 2 + (h)) * HTB)
#define PG8_SB(b, h) ((4 + (b) * 2 + (h)) * HTB)
#define PG8_STAGE(bufoff, gbase, voff) do { _Pragma("unroll") for (int _i = 0; _i < 2; ++_i) \
        __builtin_amdgcn_global_load_lds((const unsigned*)((const char*)(gbase) + (voff)[_i]), (LAS unsigned*)(lds + (bufoff) + ldsw + _i * 8192), 16, 0, 0); } while (0)
    const LAS unsigned char* rdA = lds + aoff; const LAS unsigned char* rdB = lds + 4 * HTB + boff; asm volatile("" : "+v"(rdA), "+v"(rdB));
#define PG8_LD16A(off) (*(const LAS i32x4*)(rdA + (off)))
#define PG8_LD16B(off) (*(const LAS i32x4*)(rdB + (off)))
#define PG8_LDA(dst, b, h) do { _Pragma("unroll") for (int m = 0; m < 4; ++m) dst[m] = __builtin_shufflevector(PG8_LD16A(PG8_SA(b, h) + m * 2048), PG8_LD16A(PG8_SA(b, h) + m * 2048 + 1024), 0, 1, 2, 3, 4, 5, 6, 7); } while (0)
#define PG8_LDB(dst, b, h) do { _Pragma("unroll") for (int n = 0; n < 2; ++n) dst[n] = __builtin_shufflevector(PG8_LD16B(PG8_SB(b, h) - 4 * HTB + n * 2048), PG8_LD16B(PG8_SB(b, h) - 4 * HTB + n * 2048 + 1024), 0, 1, 2, 3, 4, 5, 6, 7); } while (0)
#define PG8_LO(x) __builtin_bit_cast(bf16x8, __builtin_shufflevector(x, x, 0, 1, 2, 3))
#define PG8_HI(x) __builtin_bit_cast(bf16x8, __builtin_shufflevector(x, x, 4, 5, 6, 7))
#define PG8_MMA(ai, bj, At, Bt) do { __builtin_amdgcn_s_setprio(1); _Pragma("unroll") for (int m = 0; m < 4; ++m) _Pragma("unroll") for (int n = 0; n < 2; ++n) { \
        if constexpr (FP8) asm volatile("v_mfma_f32_16x16x128_f8f6f4 %0, %1, %2, %0" : "+v"(acc[ai][bj][m][n]) : "v"(Bt[n]), "v"(At[m])); \
        else { acc[ai][bj][m][n] = __builtin_amdgcn_mfma_f32_16x16x32_bf16(PG8_LO(Bt[n]), PG8_LO(At[m]), acc[ai][bj][m][n], 0, 0, 0); \
               acc[ai][bj][m][n] = __builtin_amdgcn_mfma_f32_16x16x32_bf16(PG8_HI(Bt[n]), PG8_HI(At[m]), acc[ai][bj][m][n], 0, 0, 0); } } \
        __builtin_amdgcn_s_setprio(0); } while (0)
#define PG8_WAIT_V(n) asm volatile("s_waitcnt vmcnt(" #n ")" ::: "memory")
#define PG8_WAIT_L(n) asm volatile("s_waitcnt lgkmcnt(" #n ")" ::: "memory")
#define PG8_BAR __builtin_amdgcn_s_barrier()
#define PG8_SCHED __builtin_amdgcn_sched_barrier(0)
    Unit cur, nxt; int ui = 0;
    if (!S.next(0, cur)) return;
    f32x4 acc[2][2][4][2];
#pragma unroll
    for (int a = 0; a < 2; ++a)
#pragma unroll
        for (int b = 0; b < 2; ++b)
#pragma unroll
            for (int m = 0; m < 4; ++m)
#pragma unroll
                for (int n = 0; n < 2; ++n) acc[a][b][m][n] = (f32x4){0.f, 0.f, 0.f, 0.f};
    const int sc1 = 0x7f7f7f7f;
    i32x8 At[4], B0[2], B1[2];
    const char* cA = (const char*)g.A + (size_t)cur.pm * tstep; const char* cB = (const char*)g.Bt + (size_t)cur.pn * tstep;
    S.a_ready(cur);
    if constexpr (GATHER) { PG8_GOFF(cur, gc); }
    {
        PG8_STAGE(PG8_SB(0, 0), cB, voffB); PG8_STAGE(PG8_SB(0, 1), cB + hstep, voffB); PG8_STAGE_A(PG8_SA(0, 0), cA, 0, false, 0); PG8_STAGE_A(PG8_SA(0, 1), cA + hstep, 1, false, 0);
        if (wr == 1) PG8_BAR;
        PG8_WAIT_V(2); PG8_BAR;
        PG8_STAGE(PG8_SB(1, 0), cB + kstep, voffB); PG8_STAGE(PG8_SB(1, 1), cB + hstep + kstep, voffB);
        PG8_WAIT_V(4); PG8_BAR;
    }
    for (;;) {
        const bool has_next = S.next(ui + 1, nxt);
        const char* nA = has_next ? (const char*)g.A + (size_t)nxt.pm * tstep : cA; const char* nB = has_next ? (const char*)g.Bt + (size_t)nxt.pn * tstep : cB;
        if constexpr (GATHER) { if (has_next) { PG8_GOFF(nxt, gn); } else { gn[0][0] = gc[0][0]; gn[0][1] = gc[0][1]; gn[1][0] = gc[1][0]; gn[1][1] = gc[1][1]; } }
        for (int t = 0; t < nt; t += 2) {
            const bool last = (t == nt - 2);
            const char* a1 = cA + (size_t)(t + 1) * kstep;
            const char* a2 = last ? nA : cA + (size_t)(t + 2) * kstep; const char* b2 = last ? nB : cB + (size_t)(t + 2) * kstep;
            const char* b3 = b2 + kstep;
            if (last && has_next) S.a_ready(nxt);
            PG8_LDB(B0, 0, 0); PG8_LDB(B1, 0, 1); PG8_SCHED; PG8_LDA(At, 0, 0); PG8_STAGE_A(PG8_SA(1, 0), a1, 0, false, (unsigned)(t + 1) * 128u); PG8_STAGE_A(PG8_SA(1, 1), a1 + hstep, 1, false, (unsigned)(t + 1) * 128u);
            PG8_WAIT_V(8); PG8_WAIT_L(0); PG8_BAR; PG8_MMA(0, 0, At, B0); PG8_MMA(0, 1, At, B1); PG8_BAR; PG8_SCHED;
            PG8_LDA(At, 0, 1); PG8_STAGE(PG8_SB(0, 0), b2, voffB); PG8_STAGE(PG8_SB(0, 1), b2 + hstep, voffB);
            PG8_WAIT_V(6); PG8_WAIT_L(0); PG8_BAR; PG8_MMA(1, 0, At, B0); PG8_MMA(1, 1, At, B1); PG8_BAR; PG8_SCHED;
            PG8_LDB(B0, 1, 0); PG8_LDB(B1, 1, 1); PG8_SCHED; PG8_LDA(At, 1, 0); PG8_STAGE_A(PG8_SA(0, 0), a2, 0, last, last ? 0u : (unsigned)(t + 2) * 128u); PG8_STAGE_A(PG8_SA(0, 1), a2 + hstep, 1, last, last ? 0u : (unsigned)(t + 2) * 128u);
            PG8_WAIT_V(8); PG8_WAIT_L(0); PG8_BAR; PG8_MMA(0, 0, At, B0); PG8_MMA(0, 1, At, B1); PG8_BAR; PG8_SCHED;
            PG8_LDA(At, 1, 1); PG8_STAGE(PG8_SB(1, 0), b3, voffB); PG8_STAGE(PG8_SB(1, 1), b3 + hstep, voffB);
            PG8_WAIT_V(6); PG8_WAIT_L(0); PG8_BAR; PG8_MMA(1, 0, At, B0); PG8_MMA(1, 1, At, B1); PG8_BAR; PG8_SCHED;
        }
        if constexpr (ALIGN_EPI) { if (wr == 0) PG8_BAR; }
        if constexpr (FP8) asm volatile("s_nop 15\n\ts_nop 15" ::: "memory");
        E(acc, cur, wr, wc, fr, fq); S.done(cur);
        if (!has_next) break;
#pragma unroll
        for (int a = 0; a < 2; ++a)
#pragma unroll
            for (int b = 0; b < 2; ++b)
#pragma unroll
                for (int m = 0; m < 4; ++m)
#pragma unroll
                    for (int n = 0; n < 2; ++n) acc[a][b][m][n] = (f32x4){0.f, 0.f, 0.f, 0.f};
        cur = nxt; cA = nA; cB = nB; ++ui;
        if constexpr (GATHER) { gc[0][0] = gn[0][0]; gc[0][1] = gn[0][1]; gc[1][0] = gn[1][0]; gc[1][1] = gn[1][1]; }
        if constexpr (ALIGN_EPI) { if (wr == 1) PG8_BAR; }
    }
    PG8_WAIT_V(0);
    if constexpr (!ALIGN_EPI) { if (wr == 0) PG8_BAR; }
    PG8_BAR;
#undef PG8_SA
#undef PG8_SB
#undef PG8_STAGE
#undef PG8_STAGE_G
#undef PG8_STAGE_A
#undef PG8_GOFF
#undef PG8_LDA
#undef PG8_LD16A
#undef PG8_LD16B
#undef PG8_LO
#undef PG8_HI
#undef PG8_LDB
#undef PG8_MMA
#undef PG8_WAIT_V
#undef PG8_WAIT_L
#undef PG8_BAR
#undef PG8_SCHED
}
}

constexpr int D = 2048, NB = 4, T = 4096, TC = 256;
constexpr int M_LAT = NB * T, M_CTX = NB * TC, M_ALL = M_LAT + M_CTX;
constexpr int DC = 1024, DR = 1024, HS = 64, NH = 16, WL = 64, AL = 64, GL = 160;
constexpr int P_STATE = 2304, P_RWKV = 3488, P_IN = 6560, P_PAD = 6720, Q0 = 3 * DC;
constexpr int NE = 32, TOPK = 4, DE = 2048, EB = 256;
constexpr int MAXBLK = (M_LAT * TOPK) / EB + NE, NSLOT = MAXBLK * EB;
constexpr int NMOD = 6 * D;
constexpr float RMS_EPS = 1e-6f, LNX_EPS = 64e-5f, KK_EPS = 1e-24f;
constexpr int NWAVES = 8, NTHR = 512;
constexpr int RR = 16, RCAP = 2048;
constexpr float WSCALE = 64.0f;
constexpr int LOWW = 2 * WL + 2 * AL + GL, LOWP = LOWW + 8;

constexpr size_t MiB = 1u << 20;
constexpr size_t WS_CTL = 0, CTL_ZERO_BYTES = 128 * 1024;
constexpr size_t WS_MOD = 1 * MiB;
constexpr size_t WS_WIN = 2 * MiB;
constexpr size_t WS_WOUT = 28 * MiB;
constexpr size_t WS_WGU = 36 * MiB;
constexpr size_t WS_WDN = 548 * MiB;
constexpr size_t WS_H = 804 * MiB;
constexpr size_t WS_P = 872 * MiB;
constexpr size_t WS_SC = 1096 * MiB, SC_STRIDE = 68 * MiB;
constexpr size_t WS_SB = WS_SC + 2 * SC_STRIDE, SB_STRIDE = 34 * MiB;
enum { SB_KD = 0, SB_BB = 2, SB_NKK = 4, SB_V = 5, SB_R = 6 };
constexpr size_t WS_G = WS_SC + 9 * SC_STRIDE;
constexpr size_t WS_Y = WS_G + 64 * MiB;
constexpr size_t WS_MIXIN = WS_Y + 128 * MiB;
constexpr size_t WS_MIX = WS_MIXIN + 64 * MiB;
constexpr size_t WS_X1 = WS_MIX + 128 * MiB;
constexpr size_t WS_H2 = WS_X1 + 128 * MiB;
constexpr size_t WS_ROUTE = WS_H2 + 64 * MiB;
constexpr size_t WS_MODP = WS_ROUTE + 7 * MiB;
constexpr size_t WS_WT = WS_ROUTE + 6 * MiB;
constexpr size_t WS_XG = WS_ROUTE + 8 * MiB;
constexpr size_t WS_ACT = WS_XG + 288 * MiB;
constexpr size_t WS_YM = WS_ACT + 288 * MiB;
constexpr size_t WS_END = WS_YM + 288 * MiB;
constexpr int CW_TMO = 0, CW_BAR = 4096, CW_CNT = 8192;

constexpr int RING_BYTES = 131072, MISC_OFF = RING_BYTES, TAB_OFF = RING_BYTES + 256, RP_OFF = RING_BYTES + 768, LIST_OFF = RING_BYTES + 3072, STG_OFF = RING_BYTES + 4096, LDS_BYTES = STG_OFF + 4 * 32 * 144 + 512;

#define XB_TMO      128
#define XB_XCNT(j)  (256  + 64 * (j))
#define XB_XSUB(j)  (1280 + 64 * (j))
#define XB_XGEN(j)  (2304 + 64 * (j))
#define XB_TOP      3328
#define XB_TOPGEN   3392
#define XCD_BAR_WORDS 3456
#define XB_SPIN_CAP (1u << 18)
__device__ __forceinline__ unsigned xb_ld(unsigned* p)              { return __hip_atomic_load(p, __ATOMIC_RELAXED, __HIP_MEMORY_SCOPE_AGENT); }
__device__ __forceinline__ unsigned xb_add(unsigned* p, unsigned v) { return __hip_atomic_fetch_add(p, v, __ATOMIC_RELAXED, __HIP_MEMORY_SCOPE_AGENT); }
__device__ __forceinline__ unsigned xb_xcc_id() { return (unsigned)__builtin_amdgcn_s_getreg((3 << 11) | 20) & 0xFu; }
#define XB_SPIN(cond, bar) do { unsigned _sp = 0; while (cond) { __builtin_amdgcn_s_sleep(1); \
    if ((++_sp & 255u) == 0u) { if (xb_ld(&(bar)[XB_TMO])) break; if (_sp > XB_SPIN_CAP) { atomicAdd(&(bar)[XB_TMO], 1u); break; } } } } while (0)
struct XcdBarrier { unsigned* bar; unsigned x; volatile LAS unsigned* st; };
__device__ __forceinline__ XcdBarrier xcd_barrier_post(unsigned* bar, volatile LAS unsigned* st) {
    XcdBarrier b; b.bar = bar; b.x = xb_xcc_id(); b.st = st;
    if (threadIdx.x == 0) (void)xb_add(&bar[XB_XCNT(b.x)], 1u);
    return b;
}
__device__ __forceinline__ void xcd_barrier_complete(unsigned* bar, unsigned x, unsigned& nloc, unsigned& nx) {
    const unsigned G = gridDim.x * gridDim.y * gridDim.z;
    unsigned sum, cnt, mine, sp = 0u;
    for (;;) {
        sum = 0u; cnt = 0u; mine = 0u;
#pragma unroll
        for (unsigned j = 0; j < 16; ++j) { const unsigned c = xb_ld(&bar[XB_XCNT(j)]); sum += c; cnt += (c > 0u) ? 1u : 0u; mine = (j == x) ? c : mine; }
        if (sum == G) break;
        __builtin_amdgcn_s_sleep(1);
        if ((++sp & 255u) == 0u) { if (xb_ld(&bar[XB_TMO])) break; if (sp > XB_SPIN_CAP) { atomicAdd(&bar[XB_TMO], 1u); break; } }
    }
    nloc = mine > 0u ? mine : 1u; nx = cnt > 0u ? cnt : 1u;
}
__device__ __forceinline__ void xcd_barrier(const XcdBarrier& b) {
    asm volatile("s_waitcnt vmcnt(0)" ::: "memory");
    __syncthreads();
    if (threadIdx.x == 0) {
        unsigned* bar = b.bar;
        __builtin_amdgcn_s_waitcnt(0);
        unsigned nloc = b.st[0], nx = b.st[1];
        if (nloc == 0u) { xcd_barrier_complete(bar, b.x, nloc, nx); b.st[0] = nloc; b.st[1] = nx; }
        const unsigned old = xb_add(&bar[XB_XSUB(b.x)], 1u);
        const unsigned gen = old / nloc;
        if (old + 1u == (gen + 1u) * nloc) {
            __builtin_amdgcn_fence(__ATOMIC_RELEASE, "agent");
            asm volatile("s_waitcnt vmcnt(0)" ::: "memory");
            const unsigned og = xb_add(&bar[XB_TOP], 1u);
            const unsigned tg = og / nx;
            if (og + 1u == (tg + 1u) * nx) xb_add(&bar[XB_TOPGEN], 1u);
            else XB_SPIN(xb_ld(&bar[XB_TOPGEN]) == tg, bar);
            __builtin_amdgcn_fence(__ATOMIC_ACQUIRE, "agent");
            xb_add(&bar[XB_XGEN(b.x)], 1u);
            asm volatile("s_waitcnt vmcnt(0)" ::: "memory");
        } else {
            XB_SPIN(xb_ld(&bar[XB_XGEN(b.x)]) == gen, bar);
            __builtin_amdgcn_fence(__ATOMIC_ACQUIRE, "agent");
            asm volatile("s_waitcnt vmcnt(0)" ::: "memory");
        }
    }
    __syncthreads();
}

struct Frame {
    LAS unsigned char* lds;
    int tid, lane, wave, G, bx;
    const float* in[27];
    float* out; unsigned char* ws;
};
#define IN_X        (F.in[0])
#define IN_C        (F.in[1])
#define IN_CTX      (F.in[2])
#define IN_CCTX     (F.in[3])
#define IN_WMOD     (F.in[4])
#define IN_BMOD     (F.in[5])
#define IN_NORMG    (F.in[6])
#define IN_WIN      (F.in[7])
#define IN_CONVW    (F.in[8])
#define IN_MU       (F.in[9])
#define IN_W0       (F.in[10])
#define IN_WUP      (F.in[11])
#define IN_A0       (F.in[12])
#define IN_AUP      (F.in[13])
#define IN_KK       (F.in[14])
#define IN_KA       (F.in[15])
#define IN_RK       (F.in[16])
#define IN_LNXW     (F.in[17])
#define IN_LNXB     (F.in[18])
#define IN_GUP      (F.in[19])
#define IN_WOUT     (F.in[20])
#define IN_WROUTER  (F.in[21])
#define IN_BROUTER  (F.in[22])
#define IN_WGU      (F.in[23])
#define IN_BGU      (F.in[24])
#define IN_WDN      (F.in[25])
#define IN_BDN      (F.in[26])
#define WSP(T_, off) ((T_*)(F.ws + (off)))

#define LDS_WAIT() asm volatile("s_waitcnt lgkmcnt(0)" ::: "memory")
__device__ __forceinline__ float bf2f(bf16_t v) { return __builtin_bit_cast(float, (unsigned)v << 16); }
__device__ __forceinline__ unsigned f2bf(float f) { unsigned u = __builtin_bit_cast(unsigned, f); return (u + 0x7fffu + ((u >> 16) & 1u)) >> 16; }
__device__ __forceinline__ unsigned pk2(float lo, float hi) { return f2bf(lo) | (f2bf(hi) << 16); }
__device__ __forceinline__ float wave_sum(float v) {
    v += __builtin_bit_cast(float, __builtin_amdgcn_update_dpp(0, __builtin_bit_cast(int, v), 0xB1, 0xF, 0xF, true));
    v += __builtin_bit_cast(float, __builtin_amdgcn_update_dpp(0, __builtin_bit_cast(int, v), 0x4E, 0xF, 0xF, true));
    v += __builtin_bit_cast(float, __builtin_amdgcn_update_dpp(0, __builtin_bit_cast(int, v), 0x124, 0xF, 0xF, true));
    v += __builtin_bit_cast(float, __builtin_amdgcn_update_dpp(0, __builtin_bit_cast(int, v), 0x128, 0xF, 0xF, true));
    const int vi = __builtin_bit_cast(int, v);
    return (__builtin_bit_cast(float, __builtin_amdgcn_readlane(vi, 0)) + __builtin_bit_cast(float, __builtin_amdgcn_readlane(vi, 16)))
         + (__builtin_bit_cast(float, __builtin_amdgcn_readlane(vi, 32)) + __builtin_bit_cast(float, __builtin_amdgcn_readlane(vi, 48)));
}
__device__ __forceinline__ float sigmoidf_(float x) { return __builtin_amdgcn_rcpf(1.0f + __expf(-x)); }

struct TrTile { const float* src; unsigned char* dst; int N, ncols, fp8; };
__device__ __forceinline__ TrTile p0_decode(Frame& F, int it) {
    constexpr int T_IN = 16 * (P_PAD / 256);
    const bool is_in = it < T_IN; const int r = is_in ? it : it - T_IN;
    const float* W = is_in ? IN_WIN : IN_WOUT; unsigned char* WT = is_in ? WSP(unsigned char, WS_WIN) : WSP(unsigned char, WS_WOUT); const int N = is_in ? P_IN : D;
    const int nblk = (N + 255) / 256, kb = r / nblk, nb = r % nblk;
    TrTile t; t.src = W + (size_t)(128 * kb) * N + 256 * nb; t.dst = WT + ((size_t)(256 * nb) * D + 128 * kb) * 2; t.N = N; t.ncols = (N - 256 * nb) < 256 ? (N - 256 * nb) : 256; t.fp8 = 0; return t;
}
#define P0_LOAD(v, t) do { const bool _ok = 4 * F.lane < (t).ncols; const float* _s = (t).src + (size_t)(16 * F.wave) * (t).N + 4 * F.lane; \
    _Pragma("unroll") for (int i = 0; i < 16; ++i) v[i] = _ok ? *(const f32x4*)(_s + (size_t)i * (t).N) : (f32x4){0.f, 0.f, 0.f, 0.f}; } while (0)
__device__ __forceinline__ void p0_store_tile(Frame& F, const f32x4 (&v)[16], const TrTile& t) {
    LAS unsigned char* tile = F.lds;
    if (t.fp8) {
#pragma unroll
        for (int j = 0; j < 4; ++j) { const int n = 4 * F.lane + j; u32x4 w;
            w.x = pg8::pk4_fp8(v[0][j] * WSCALE, v[1][j] * WSCALE, v[2][j] * WSCALE, v[3][j] * WSCALE); w.y = pg8::pk4_fp8(v[4][j] * WSCALE, v[5][j] * WSCALE, v[6][j] * WSCALE, v[7][j] * WSCALE);
            w.z = pg8::pk4_fp8(v[8][j] * WSCALE, v[9][j] * WSCALE, v[10][j] * WSCALE, v[11][j] * WSCALE); w.w = pg8::pk4_fp8(v[12][j] * WSCALE, v[13][j] * WSCALE, v[14][j] * WSCALE, v[15][j] * WSCALE);
            *(LAS u32x4*)(tile + n * 128 + ((F.wave ^ ((n >> 2) & 7)) << 4)) = w; }
        __syncthreads();
#pragma unroll
        for (int j = 0; j < 4; ++j) { const int n = 32 * F.wave + (F.lane >> 3) + 8 * j, c = F.lane & 7;
            if (n < t.ncols) *(u32x4*)(t.dst + (size_t)n * D + 16 * c) = *(const LAS u32x4*)(tile + n * 128 + ((c ^ ((n >> 2) & 7)) << 4)); }
        __syncthreads();
        return;
    }
#pragma unroll
    for (int j = 0; j < 4; ++j) { const int n = 4 * F.lane + j;
#pragma unroll
        for (int hc = 0; hc < 2; ++hc) { u32x4 w;
            w.x = pg8::cvt_pk_bf16(v[8 * hc + 0][j], v[8 * hc + 1][j]); w.y = pg8::cvt_pk_bf16(v[8 * hc + 2][j], v[8 * hc + 3][j]);
            w.z = pg8::cvt_pk_bf16(v[8 * hc + 4][j], v[8 * hc + 5][j]); w.w = pg8::cvt_pk_bf16(v[8 * hc + 6][j], v[8 * hc + 7][j]);
            *(LAS u32x4*)(tile + n * 256 + (((2 * F.wave + hc) ^ ((n >> 2) & 15)) << 4)) = w; } }
    __syncthreads();
#pragma unroll
    for (int j = 0; j < 8; ++j) { const int n = 32 * F.wave + (F.lane >> 4) + 4 * j, c = F.lane & 15;
        if (n < t.ncols) *(u32x4*)(t.dst + ((size_t)n * D + 8 * c) * 2) = *(const LAS u32x4*)(tile + n * 256 + ((c ^ ((n >> 2) & 15)) << 4)); }
    __syncthreads();
}
__device__ __forceinline__ void p0_prologue(Frame& F) {
    for (int u = F.bx; u < (NMOD / 256) * 4; u += F.G) {
        const int nb = u >> 2, kq = u & 3;
        LAS float* sl = (LAS float*)F.lds;
        LAS float* red = (LAS float*)(F.lds + 16384);
        __syncthreads();
        for (int i = F.tid; i < 5 * 512; i += NTHR) { const int r = i >> 9, k = 512 * kq + (i & 511); const float cv = r < 4 ? IN_C[r * D + k] : IN_CCTX[k]; sl[i] = cv / (1.0f + __expf(-cv)); }
        __syncthreads();
        f32x4 acc[5];
#pragma unroll
        for (int r = 0; r < 5; ++r) acc[r] = (f32x4){0.f, 0.f, 0.f, 0.f};
        const int kl = F.wave * 64;
        const float* wp = IN_WMOD + (size_t)(512 * kq + kl) * NMOD + nb * 256 + F.lane * 4;
#pragma unroll 16
        for (int k = 0; k < 64; ++k) { const f32x4 w = *(const f32x4*)(wp + (size_t)k * NMOD);
#pragma unroll
            for (int r = 0; r < 5; ++r) acc[r] += sl[r * 512 + kl + k] * w; }
#pragma unroll
        for (int r = 0; r < 5; ++r) *(LAS f32x4*)(red + (F.wave * 5 + r) * 256 + F.lane * 4) = acc[r];
        __syncthreads();
        float* modp = WSP(float, WS_MODP) + (size_t)kq * 5 * NMOD;
        for (int o = F.tid; o < 5 * 256; o += NTHR) { const int r = o / 256, col = o % 256; float s = 0.f;
#pragma unroll
            for (int w = 0; w < 8; ++w) s += red[(w * 5 + r) * 256 + col];
            modp[r * NMOD + nb * 256 + col] = s; }
        __syncthreads();
    }
    {
        constexpr int NTILES = 16 * (P_PAD / 256) + 16 * (D / 256);
        f32x4 va[16], vb[16];
        int it = F.bx;
        TrTile ta, tb; ta = p0_decode(F, it < NTILES ? it : 0); tb = ta;
        if (it < NTILES) P0_LOAD(va, ta);
        while (it < NTILES) {
            const int it1 = it + F.G;
            if (it1 < NTILES) { tb = p0_decode(F, it1); P0_LOAD(vb, tb); }
            p0_store_tile(F, va, ta);
            if (it1 >= NTILES) break;
            const int it2 = it1 + F.G;
            if (it2 < NTILES) { ta = p0_decode(F, it2); P0_LOAD(va, ta); }
            p0_store_tile(F, vb, tb);
            it = it2;
        }
    }
    {
        bf16_t* WT = WSP(bf16_t, WS_WT);
        for (int idx = F.bx * NTHR + F.tid; idx < LOWW * DR; idx += F.G * NTHR) { const int j = idx / DR, c = idx % DR;
            const float v = j < 128 ? IN_WUP[(size_t)j * DR + c] : j < 256 ? IN_AUP[(size_t)(j - 128) * DR + c] : IN_GUP[(size_t)(j - 256) * DR + c];
            WT[(size_t)c * LOWW + j] = (bf16_t)f2bf(v); }
    }
}

__device__ __forceinline__ void p1_norm(Frame& F) {
    const float* modp = WSP(float, WS_MODP); float* mod = WSP(float, WS_MOD); bf16_t* H = WSP(bf16_t, WS_H);
    for (int idx = F.bx * NTHR + F.tid; idx < 5 * NMOD; idx += F.G * NTHR)
        mod[idx] = ((modp[idx] + modp[5 * NMOD + idx]) + (modp[2 * 5 * NMOD + idx] + modp[3 * 5 * NMOD + idx])) + IN_BMOD[idx % NMOD];
    LAS float* gs = (LAS float*)F.lds;
    LAS float* sh = gs + D;
    const int rpw = (M_ALL + F.G - 1) / F.G, r0 = F.bx * rpw, r1 = (r0 + rpw) < M_ALL ? (r0 + rpw) : M_ALL;
    int cur = -1;
    for (int rb = r0; rb < r1; rb += NWAVES) {
        const int b0 = rb < M_LAT ? rb / T : 4;
        if (b0 != cur) {
            __syncthreads();
            for (int c = F.tid; c < D; c += NTHR) { const int i0 = b0 * NMOD + c, i1 = b0 * NMOD + D + c;
                const float shv = ((modp[i0] + modp[5 * NMOD + i0]) + (modp[2 * 5 * NMOD + i0] + modp[3 * 5 * NMOD + i0])) + IN_BMOD[c];
                const float scv = ((modp[i1] + modp[5 * NMOD + i1]) + (modp[2 * 5 * NMOD + i1] + modp[3 * 5 * NMOD + i1])) + IN_BMOD[D + c];
                gs[c] = IN_NORMG[c] * (1.0f + scv); sh[c] = shv; }
            __syncthreads();
            cur = b0;
        }
        const int row = rb + F.wave;
        const int bw = row < M_LAT ? row / T : 4;
        if (row < r1 && bw == b0) {
            const float* xr = row < M_LAT ? IN_X + (size_t)row * D : IN_CTX + (size_t)(row - M_LAT) * D;
            f32x4 v[8]; float ss = 0.f;
#pragma unroll
            for (int j = 0; j < 8; ++j) { v[j] = *(const f32x4*)(xr + 4 * F.lane + 256 * j); ss += (v[j].x * v[j].x + v[j].y * v[j].y) + (v[j].z * v[j].z + v[j].w * v[j].w); }
            const float rstd = __builtin_amdgcn_rsqf(wave_sum(ss) * (1.0f / D) + RMS_EPS);
#pragma unroll
            for (int j = 0; j < 8; ++j) { const int c = 4 * F.lane + 256 * j;
                const f32x4 o = (v[j] * rstd) * *(const LAS f32x4*)(gs + c) + *(const LAS f32x4*)(sh + c);
                u32x2 w; w.x = pg8::cvt_pk_bf16(o.x, o.y); w.y = pg8::cvt_pk_bf16(o.z, o.w);
                *(u32x2*)(H + (size_t)row * D + c) = w; }
        }
        if (rb + NWAVES - 1 < r1 || true) { const int lastrow = (rb + NWAVES - 1) < r1 ? (rb + NWAVES - 1) : (r1 - 1); const int bl = lastrow < M_LAT ? lastrow / T : 4;
            if (bl != b0) {
                __syncthreads();
                for (int c = F.tid; c < D; c += NTHR) { const int i0 = bl * NMOD + c, i1 = bl * NMOD + D + c;
                    const float shv = ((modp[i0] + modp[5 * NMOD + i0]) + (modp[2 * 5 * NMOD + i0] + modp[3 * 5 * NMOD + i0])) + IN_BMOD[c];
                    const float scv = ((modp[i1] + modp[5 * NMOD + i1]) + (modp[2 * 5 * NMOD + i1] + modp[3 * 5 * NMOD + i1])) + IN_BMOD[D + c];
                    gs[c] = IN_NORMG[c] * (1.0f + scv); sh[c] = shv; }
                __syncthreads();
                cur = bl;
                if (row < r1 && bw == bl) {
                    const float* xr = row < M_LAT ? IN_X + (size_t)row * D : IN_CTX + (size_t)(row - M_LAT) * D;
                    f32x4 v[8]; float ss = 0.f;
#pragma unroll
                    for (int j = 0; j < 8; ++j) { v[j] = *(const f32x4*)(xr + 4 * F.lane + 256 * j); ss += (v[j].x * v[j].x + v[j].y * v[j].y) + (v[j].z * v[j].z + v[j].w * v[j].w); }
                    const float rstd = __builtin_amdgcn_rsqf(wave_sum(ss) * (1.0f / D) + RMS_EPS);
#pragma unroll
                    for (int j = 0; j < 8; ++j) { const int c = 4 * F.lane + 256 * j;
                        const f32x4 o = (v[j] * rstd) * *(const LAS f32x4*)(gs + c) + *(const LAS f32x4*)(sh + c);
                        u32x2 w; w.x = pg8::cvt_pk_bf16(o.x, o.y); w.y = pg8::cvt_pk_bf16(o.z, o.w);
                        *(u32x2*)(H + (size_t)row * D + c) = w; }
                }
            }
        }
    }
}

__device__ __forceinline__ void static_unit(int L, int nM, int nN, int& pm, int& pn) {
    const int nwg = nM * nN; int wgid = L;
    { const int q = nwg / 8, r = nwg % 8, xcd = wgid % 8, off = wgid / 8; wgid = (xcd < r ? xcd * (q + 1) : r * (q + 1) + (xcd - r) * q) + off; }
    const int nig = 8 * nN, gid = wgid / nig, fm = gid * 8, gsz = (nM - fm) < 8 ? (nM - fm) : 8;
    pm = fm + ((wgid % nig) % gsz); pn = (wgid % nig) / gsz;
}
__device__ __forceinline__ void build_tab(Frame& F) {
    LAS int* tab = (LAS int*)(F.lds + TAB_OFF); LAS int* rp = (LAS int*)(F.lds + RP_OFF);
    if (F.tid < NE) { const unsigned* cnt = WSP(unsigned, WS_CTL) + CW_CNT; int run = 0;
#pragma unroll
        for (int r = 0; r < RR; ++r) { rp[F.tid * RR + r] = run; run += (int)__hip_atomic_load(cnt + (r * NE + F.tid) * 16, __ATOMIC_RELAXED, __HIP_MEMORY_SCOPE_AGENT); }
        tab[64 + F.tid] = run; }
    __syncthreads();
    if (F.tid == 0) { int run = 0;
        for (int e = 0; e < NE; ++e) { tab[e] = run; run += ((tab[64 + e] + EB - 1) / EB) * EB; }
        tab[32] = run; }
    __syncthreads();
}
__device__ __forceinline__ int build_list(Frame& F, int mode) {
    LAS int* list = (LAS int*)(F.lds + LIST_OFF); const LAS int* tab = (const LAS int*)(F.lds + TAB_OFF);
    int total;
    if (mode == 0) total = 64 * 26 + 4 * 9; else if (mode == 1) total = 64 * 8; else total = (tab[32] / EB) * (mode == 2 ? 16 : 8);
    const int c = F.bx; const int n = c < total ? (total - c + F.G - 1) / F.G : 0;
    if (F.tid < n && F.tid < 64) {
        const int L = F.tid * F.G + c; int pm, pn;
        if (mode == 0) { if (L < 64 * 26) static_unit(L, 64, 26, pm, pn); else { const int r = L - 64 * 26; pm = 64 + (r & 3); pn = 12 + (r >> 2); } }
        else if (mode == 1) static_unit(L, 64, 8, pm, pn);
        else { const int NT = mode == 2 ? 16 : 8; int wgid = L;
            { const int q = total / 8, r = total % 8, xcd = wgid % 8, off = wgid / 8; wgid = (xcd < r ? xcd * (q + 1) : r * (q + 1) + (xcd - r) * q) + off; }
            int e = 0, ustart = 0;
            for (; e < NE - 1; ++e) { const int nb = (tab[e + 1] - tab[e]) / EB; if (wgid < ustart + nb * NT) break; ustart += nb * NT; }
            const int nb = (tab[e + 1] - tab[e]) / EB, re = wgid - ustart, j = re / (8 * NT), r = re - j * 8 * NT, gsz = (nb - 8 * j) < 8 ? (nb - 8 * j) : 8;
            pm = tab[e] / EB + 8 * j + r % gsz; pn = e * NT + r / gsz; }
        list[2 * F.tid] = pm; list[2 * F.tid + 1] = pn;
    }
    __syncthreads();
    return n < 64 ? n : 64;
}

__device__ __forceinline__ float qshift(const bf16_t* p, int gr, int s0, int s1, int col, float mu0, float mu1) {
    const float c = bf2f(p[(size_t)gr * P_PAD + Q0 + col]);
    const float pv = gr > s0 ? bf2f(p[(size_t)(gr - 1) * P_PAD + Q0 + col]) : 0.f;
    const float nx = gr + 1 < s1 ? bf2f(p[(size_t)(gr + 1) * P_PAD + Q0 + col]) : 0.f;
    return c + mu0 * (pv - c) + mu1 * (nx - c);
}
__device__ __forceinline__ f32x4 ld_bf4(const bf16_t* p) { const u32x2 w = *(const u32x2*)p; return (f32x4){__builtin_bit_cast(float, w.x << 16), __builtin_bit_cast(float, w.x & 0xffff0000u), __builtin_bit_cast(float, w.y << 16), __builtin_bit_cast(float, w.y & 0xffff0000u)}; }
__device__ __forceinline__ void ld_bf8(const bf16_t* p, f32x4& lo, f32x4& hi) { const u32x4 w = *(const u32x4*)p;
    lo = (f32x4){__builtin_bit_cast(float, w.x << 16), __builtin_bit_cast(float, w.x & 0xffff0000u), __builtin_bit_cast(float, w.y << 16), __builtin_bit_cast(float, w.y & 0xffff0000u)};
    hi = (f32x4){__builtin_bit_cast(float, w.z << 16), __builtin_bit_cast(float, w.z & 0xffff0000u), __builtin_bit_cast(float, w.w << 16), __builtin_bit_cast(float, w.w & 0xffff0000u)}; }
__device__ __forceinline__ f32x4 qshift4(const bf16_t* P, const float* mu, int gr, bool hp, bool hn, int col) {
    const bf16_t* pr = P + (size_t)gr * P_PAD + Q0 + col;
    const f32x4 c = ld_bf4(pr); const f32x4 z = (f32x4){0.f, 0.f, 0.f, 0.f};
    const f32x4 pv = hp ? ld_bf4(pr - P_PAD) : z, nx = hn ? ld_bf4(pr + P_PAD) : z;
    const f32x4 m0 = *(const f32x4*)(mu + col), m1 = *(const f32x4*)(mu + P_RWKV + col);
    return c + m0 * (pv - c) + m1 * (nx - c);
}
__device__ __forceinline__ void st_bf4(bf16_t* p, f32x4 v) { u32x2 w; w.x = pg8::cvt_pk_bf16(v.x, v.y); w.y = pg8::cvt_pk_bf16(v.z, v.w); *(u32x2*)p = w; }
__device__ __forceinline__ f32x4 sig4(f32x4 x) { return (f32x4){sigmoidf_(x.x), sigmoidf_(x.y), sigmoidf_(x.z), sigmoidf_(x.w)}; }
__device__ __forceinline__ void st_bf8(bf16_t* p, f32x4 a, f32x4 b) { u32x4 w; w.x = pg8::cvt_pk_bf16(a.x, a.y); w.y = pg8::cvt_pk_bf16(a.z, a.w); w.z = pg8::cvt_pk_bf16(b.x, b.y); w.w = pg8::cvt_pk_bf16(b.z, b.w); *(u32x4*)p = w; }
__device__ __forceinline__ void qshift16(const bf16_t* P, int gr, bool hp, bool hn, int col, const LAS float* mu0, const LAS float* mu1, f32x4 (&o)[4]) {
    const bf16_t* pr = P + (size_t)gr * P_PAD + Q0 + col;
    f32x4 c[4], pv[4], nx[4]; const f32x4 z = (f32x4){0.f, 0.f, 0.f, 0.f};
    ld_bf8(pr, c[0], c[1]); ld_bf8(pr + 8, c[2], c[3]);
    if (hp) { ld_bf8(pr - P_PAD, pv[0], pv[1]); ld_bf8(pr - P_PAD + 8, pv[2], pv[3]); } else { pv[0] = z; pv[1] = z; pv[2] = z; pv[3] = z; }
    if (hn) { ld_bf8(pr + P_PAD, nx[0], nx[1]); ld_bf8(pr + P_PAD + 8, nx[2], nx[3]); } else { nx[0] = z; nx[1] = z; nx[2] = z; nx[3] = z; }
#pragma unroll
    for (int n = 0; n < 4; ++n) o[n] = c[n] + *(const LAS f32x4*)(mu0 + 4 * n) * (pv[n] - c[n]) + *(const LAS f32x4*)(mu1 + 4 * n) * (nx[n] - c[n]);
}
__device__ __forceinline__ void p3_inputs(Frame& F) {
    LAS bf16_t* low = (LAS bf16_t*)F.lds;
    LAS float* par = (LAS float*)(F.lds + 16384) + F.wave * (2 * 13 * 64);
    const bf16_t* P = WSP(bf16_t, WS_P); const float* mu = IN_MU; const bf16_t* WT = WSP(bf16_t, WS_WT);
    bf16_t* Ub = WSP(bf16_t, WS_SC); bf16_t* SBb = WSP(bf16_t, WS_SB); bf16_t* G = WSP(bf16_t, WS_G);
    const int tok = F.lane & 15, q = F.lane >> 4;
#pragma unroll
    for (int hh = 0; hh < 2; ++hh) { const int ch = (2 * F.wave + hh) * 64 + F.lane; LAS float* pp = par + hh * 13 * 64 + F.lane; pp[12 * 64] = IN_RK[ch];
        pp[0 * 64] = IN_KK[ch]; pp[1 * 64] = IN_KA[ch]; pp[2 * 64] = IN_W0[ch]; pp[3 * 64] = IN_W0[DR + ch]; pp[4 * 64] = IN_A0[ch]; pp[5 * 64] = IN_A0[DR + ch];
        pp[6 * 64] = mu[ch]; pp[7 * 64] = mu[P_RWKV + ch]; pp[8 * 64] = mu[1024 + ch]; pp[9 * 64] = mu[P_RWKV + 1024 + ch]; pp[10 * 64] = mu[2304 + ch]; pp[11 * 64] = mu[P_RWKV + 2304 + ch]; }
    __syncthreads();
    for (int job = F.bx; job < M_LAT / 16 + 4 * (M_CTX / 16); job += F.G) {
        const bool qjob = job >= M_LAT / 16; const int tile = qjob ? M_LAT / 16 + ((job - M_LAT / 16) >> 2) : job, qtr = (job - M_LAT / 16) & 3;
        const int row0 = tile * 16; int s0, s1;
        if (row0 < M_LAT) { s0 = (row0 / T) * T; s1 = s0 + T; } else { s0 = M_LAT + ((row0 - M_LAT) / TC) * TC; s1 = s0 + TC; }
        const bool lat = row0 < M_LAT;
        __syncthreads();
        for (int i = F.tid; i < 16 * (LOWW / 4); i += NTHR) { const int tk = i / (LOWW / 4), c4 = (i % (LOWW / 4)) * 4, col = c4 < 256 ? 2048 + c4 : 3328 + (c4 - 256);
            f32x4 qv = qshift4(P, mu, row0 + tk, row0 + tk > s0, row0 + tk + 1 < s1, col);
            if (c4 < 128) qv = (f32x4){1.0f - 2.0f * __builtin_amdgcn_rcpf(1.0f + __expf(2.0f * qv.x)), 1.0f - 2.0f * __builtin_amdgcn_rcpf(1.0f + __expf(2.0f * qv.y)), 1.0f - 2.0f * __builtin_amdgcn_rcpf(1.0f + __expf(2.0f * qv.z)), 1.0f - 2.0f * __builtin_amdgcn_rcpf(1.0f + __expf(2.0f * qv.w))};
            else if (c4 >= 256) qv = sig4(qv);
            u32x2 w; w.x = pg8::cvt_pk_bf16(qv.x, qv.y); w.y = pg8::cvt_pk_bf16(qv.z, qv.w); *(LAS u32x2*)(low + tk * LOWP + c4) = w; }
        __syncthreads();
        const LAS bf16_t* afp = low + tok * LOWP + 8 * q;
        const int gr = row0 + tok; const bool hp = gr > s0, hn = gr + 1 < s1;
        const int nh = qjob ? (F.wave < 4 ? 1 : 0) : 2;
#pragma unroll 1
        for (int hh = 0; hh < nh; ++hh) {
            const int head = qjob ? 4 * qtr + F.wave : 2 * F.wave + hh; const int cb = head * 64 + 16 * q;
            const LAS float* pl = (const LAS float*)(F.lds + 16384) + head * (13 * 64) + 16 * q;
            const size_t o = (size_t)gr * DR + cb;
            f32x4 k[4], r[4];
            {   f32x4 v[4];
                qshift16(P, gr, hp, hn, cb, pl + 6 * 64, pl + 7 * 64, k); qshift16(P, gr, hp, hn, 1024 + cb, pl + 8 * 64, pl + 9 * 64, v); qshift16(P, gr, hp, hn, 2304 + cb, pl + 10 * 64, pl + 11 * 64, r);
                st_bf8(SBb + (size_t)SB_V * (SB_STRIDE / 2) + o, v[0], v[1]); st_bf8(SBb + (size_t)SB_V * (SB_STRIDE / 2) + o + 8, v[2], v[3]);
                st_bf8(SBb + (size_t)SB_R * (SB_STRIDE / 2) + o, r[0], r[1]); st_bf8(SBb + (size_t)SB_R * (SB_STRIDE / 2) + o + 8, r[2], r[3]); }
            __builtin_amdgcn_sched_barrier(0);
            f32x4 acc[4][5];
            const bf16_t* wrow0 = WT + (size_t)(head * 64 + 16 * (tok >> 2) + (tok & 3)) * LOWW + 8 * q;
            bf16x8 bwA[13], bwB[13];
#define P3_LDW(dst, n_) do { _Pragma("unroll") for (int s = 0; s < 13; ++s) dst[s] = *(const bf16x8*)(wrow0 + (size_t)(4 * (n_)) * LOWW + 32 * s); } while (0)
#define P3_MM(src, n_) do { _Pragma("unroll") for (int x = 0; x < 5; ++x) acc[n_][x] = (f32x4){0.f, 0.f, 0.f, 0.f}; \
                _Pragma("unroll") for (int s = 0; s < 13; ++s) { const int x = s < 8 ? (s >> 1) : 4; \
                    acc[n_][x] = __builtin_amdgcn_mfma_f32_16x16x32_bf16(src[s], *(const LAS bf16x8*)(afp + 32 * s), acc[n_][x], 0, 0, 0); } } while (0)
            f32x4 kr[4]; float ss = 0.f;
#pragma unroll
            for (int n = 0; n < 4; ++n) { kr[n] = k[n] * *(const LAS f32x4*)(pl + 0 * 64 + 4 * n); ss += (kr[n].x * kr[n].x + kr[n].y * kr[n].y) + (kr[n].z * kr[n].z + kr[n].w * kr[n].w); }
            ss += __shfl_xor(ss, 16); ss += __shfl_xor(ss, 32);
            const float rn = __builtin_amdgcn_rsqf(fmaxf(ss, KK_EPS));
#pragma unroll
            for (int n = 0; n < 4; ++n) kr[n] = kr[n] * rn;
            st_bf8(SBb + (size_t)SB_NKK * (SB_STRIDE / 2) + o, -kr[0], -kr[1]); st_bf8(SBb + (size_t)SB_NKK * (SB_STRIDE / 2) + o + 8, -kr[2], -kr[3]);
#define P3_EPI(NP) do { \
                _Pragma("unroll") for (int d = 0; d < 2; ++d) { f32x4 uu[2], kd[2], bb[2]; \
                    _Pragma("unroll") for (int i = 0; i < 2; ++i) { const int n = 2 * (NP) + i; \
                        uu[i] = sig4(acc[n][d] + *(const LAS f32x4*)(pl + (2 + d) * 64 + 4 * n)) * 0.60653066f;        \
                        const f32x4 a = sig4(acc[n][2 + d] + *(const LAS f32x4*)(pl + (4 + d) * 64 + 4 * n)); \
                        kd[i] = k[n] * ((a - 1.0f) * *(const LAS f32x4*)(pl + 1 * 64 + 4 * n) + 1.0f); bb[i] = kr[n] * a; \
                        { const f32x4 t_ = r[n] * kd[i] * *(const LAS f32x4*)(pl + 12 * 64 + 4 * n); bon[d] += (t_.x + t_.y) + (t_.z + t_.w); } } \
                    st_bf8(Ub + (size_t)d * (SC_STRIDE / 2) + o + 8 * (NP), uu[0], uu[1]); \
                    st_bf8(SBb + (size_t)(SB_KD + d) * (SB_STRIDE / 2) + o + 8 * (NP), kd[0], kd[1]); \
                    st_bf8(SBb + (size_t)(SB_BB + d) * (SB_STRIDE / 2) + o + 8 * (NP), bb[0], bb[1]); } \
                if (lat) st_bf8(G + o + 8 * (NP), acc[2 * (NP)][4], acc[2 * (NP) + 1][4]); } while (0)
            float bon[2] = {0.f, 0.f};
            P3_LDW(bwA, 0); P3_LDW(bwB, 1); P3_MM(bwA, 0); P3_LDW(bwA, 2); P3_MM(bwB, 1); P3_LDW(bwB, 3);
            P3_EPI(0);
            P3_MM(bwA, 2); P3_MM(bwB, 3);
            P3_EPI(1);
            if (lat) {
#pragma unroll
                for (int d = 0; d < 2; ++d) { float b_ = bon[d]; b_ += __shfl_xor(b_, 16); b_ += __shfl_xor(b_, 32); bon[d] = b_; }
                if (q == 0) *(f32x2*)(WSP(float, WS_XG) + ((size_t)gr * NH + head) * 2) = (f32x2){bon[0], bon[1]}; }
#undef P3_EPI
#undef P3_LDW
#undef P3_MM
        }
    }
    __syncthreads();
}

__device__ __forceinline__ float fma_(float a, float b, float c) { float d; asm("v_fma_f32 %0, %1, %2, %3" : "=v"(d) : "v"(a), "v"(b), "v"(c)); return d; }
__device__ __forceinline__ float mul_(float a, float b) { float d; asm("v_mul_f32 %0, %1, %2" : "=v"(d) : "v"(a), "v"(b)); return d; }
__device__ __forceinline__ float add_(float a, float b) { float d; asm("v_add_f32 %0, %1, %2" : "=v"(d) : "v"(a), "v"(b)); return d; }
template <int OFF> __device__ __forceinline__ f32x4 lds_rd128(unsigned addr) { f32x4 v; asm volatile("ds_read_b128 %0, %1 offset:%2" : "=&v"(v) : "v"(addr), "n"(OFF)); return v; }
template <int OFF> __device__ __forceinline__ float lds_rd32(unsigned addr) { float v; asm volatile("ds_read_b32 %0, %1 offset:%2" : "=&v"(v) : "v"(addr), "n"(OFF)); return v; }
__device__ __forceinline__ f32x2 pk_mul(f32x2 a, f32x2 b) { f32x2 d; asm("v_pk_mul_f32 %0, %1, %2" : "=v"(d) : "v"(a), "v"(b)); return d; }
__device__ __forceinline__ f32x2 pk_fma(f32x2 a, f32x2 b, f32x2 c) { f32x2 d; asm("v_pk_fma_f32 %0, %1, %2, %3" : "=v"(d) : "v"(a), "v"(b), "v"(c)); return d; }
__device__ __forceinline__ f32x2 pk_mul_b0(f32x2 a, f32x2 b) { f32x2 d; asm("v_pk_mul_f32 %0, %1, %2 op_sel_hi:[0,1]" : "=v"(d) : "v"(a), "v"(b)); return d; }
__device__ __forceinline__ f32x2 pk_fma_b0(f32x2 a, f32x2 b, f32x2 c) { f32x2 d; asm("v_pk_fma_f32 %0, %1, %2, %3 op_sel_hi:[0,1,1]" : "=v"(d) : "v"(a), "v"(b), "v"(c)); return d; }
__device__ __forceinline__ f32x2 pk_mul_l(f32x2 a, f32x2 b) { f32x2 d; asm("v_pk_mul_f32 %0, %1, %2 op_sel_hi:[1,0]" : "=v"(d) : "v"(a), "v"(b)); return d; }
__device__ __forceinline__ f32x2 pk_mul_h(f32x2 a, f32x2 b) { f32x2 d; asm("v_pk_mul_f32 %0, %1, %2 op_sel:[0,1] op_sel_hi:[1,1]" : "=v"(d) : "v"(a), "v"(b)); return d; }
__device__ __forceinline__ f32x2 pk_fma_l(f32x2 a, f32x2 b, f32x2 c) { f32x2 d; asm("v_pk_fma_f32 %0, %1, %2, %3 op_sel_hi:[1,0,1]" : "=v"(d) : "v"(a), "v"(b), "v"(c)); return d; }
__device__ __forceinline__ f32x2 pk_fma_h(f32x2 a, f32x2 b, f32x2 c) { f32x2 d; asm("v_pk_fma_f32 %0, %1, %2, %3 op_sel:[0,1,0] op_sel_hi:[1,1,1]" : "=v"(d) : "v"(a), "v"(b), "v"(c)); return d; }
#define LO2(v4) __builtin_shufflevector(v4, v4, 0, 1)
#define HI2(v4) __builtin_shufflevector(v4, v4, 2, 3)
template <int CTRL> __device__ __forceinline__ float dpp_add(float x) { return x + __builtin_bit_cast(float, __builtin_amdgcn_update_dpp(0, __builtin_bit_cast(int, x), CTRL, 0xF, 0xF, true)); }
template <int CTRL> __device__ __forceinline__ float dpp_mov(float x) { return __builtin_bit_cast(float, __builtin_amdgcn_update_dpp(0, __builtin_bit_cast(int, x), CTRL, 0xF, 0xF, true)); }
__device__ __forceinline__ float pair16_sum(f32x2 p) { float x = p.x + dpp_mov<0xB1>(p.y); x = dpp_add<0x4E>(x); x = dpp_add<0x124>(x); x = dpp_add<0x128>(x); return x; }
__device__ __forceinline__ float row16_sum(float x) { x = dpp_add<0xB1>(x); x = dpp_add<0x4E>(x); x = dpp_add<0x124>(x); x = dpp_add<0x128>(x); return x; }
__device__ __forceinline__ int scan_row(int step, int b, int d) {
    if (step < TC) { const int t = d ? TC - 1 - step : step; return M_LAT + b * TC + t; }
    int t = step - TC; t = d ? T - 1 - t : t; return b * T + t;
}
struct CvItem { const float* src; unsigned char* dst; int N; };
constexpr int CV_GU1 = (D / 128) * (2 * DE / 128) * 4, CV_DN1 = (DE / 128) * (D / 128) * 4, CV_ITEMS = NE * (CV_GU1 + CV_DN1);
__device__ __forceinline__ CvItem cv_decode(Frame& F, int it) {
    const float* W; unsigned char* WT; int N, row_off, r;
    if (it < NE * CV_GU1) { const int e = it / CV_GU1; r = it - e * CV_GU1; W = IN_WGU + (size_t)e * D * 2 * DE; WT = WSP(unsigned char, WS_WGU); N = 2 * DE; row_off = e * 2 * DE; }
    else { it -= NE * CV_GU1; const int e = it / CV_DN1; r = it - e * CV_DN1; W = IN_WDN + (size_t)e * DE * D; WT = WSP(unsigned char, WS_WDN); N = D; row_off = e * D; }
    const int kq = r & 3, sr = r >> 2, nblk = N / 128, kb = sr / nblk, nb = sr % nblk;
    CvItem t; t.src = W + (size_t)(128 * kb + 32 * kq) * N + 128 * nb; t.dst = WT + (size_t)(row_off + 128 * nb) * D + 128 * kb; t.N = N; return t;
}
#define CV_LOAD(v, t, lane_) do { const float* _s = (t).src + (size_t)(16 * ((lane_) >> 5)) * (t).N + 4 * ((lane_) & 31); \
    _Pragma("unroll") for (int i = 0; i < 16; ++i) v[i] = __builtin_nontemporal_load((const f32x4*)(_s + (size_t)i * (t).N)); } while (0)
__device__ __forceinline__ void cv_put(const f32x4 (&v)[16], LAS unsigned char* tile, int kq, int lane) {
    const int c = lane & 31, kg = lane >> 5;
#pragma unroll
    for (int j = 0; j < 4; ++j) { u32x4 w;
        w.x = pg8::pk4_fp8(v[0][j] * WSCALE, v[1][j] * WSCALE, v[2][j] * WSCALE, v[3][j] * WSCALE); w.y = pg8::pk4_fp8(v[4][j] * WSCALE, v[5][j] * WSCALE, v[6][j] * WSCALE, v[7][j] * WSCALE);
        w.z = pg8::pk4_fp8(v[8][j] * WSCALE, v[9][j] * WSCALE, v[10][j] * WSCALE, v[11][j] * WSCALE); w.w = pg8::pk4_fp8(v[12][j] * WSCALE, v[13][j] * WSCALE, v[14][j] * WSCALE, v[15][j] * WSCALE);
        *(LAS u32x4*)(tile + (4 * c + j) * 128 + (((2 * kq + kg) ^ (c & 7)) << 4)) = w; }
}
__device__ __forceinline__ void cv_flush(const LAS unsigned char* tile, unsigned char* dst, int kq, int lane) {
    const int c8 = lane & 7;
#pragma unroll
    for (int jj = 0; jj < 4; ++jj) { const int n = 32 * kq + (lane >> 3) + 8 * jj;
        __builtin_nontemporal_store(*(const LAS u32x4*)(tile + n * 128 + ((c8 ^ ((n >> 2) & 7)) << 4)), (u32x4*)(dst + (size_t)n * D + 16 * c8)); }
}
constexpr int SB = 32, SLOT_BYTES = 5 * SB * 256 + SB * 128, YB_OFF = 2 * SLOT_BYTES, YB_BYTES = SB * 128;
__device__ __forceinline__ float row8_sum(float x) { x = dpp_add<0xB1>(x); x = dpp_add<0x4E>(x); x = dpp_add<0x141>(x); return x; }
__device__ __forceinline__ void p4_scan(Frame& F) {
    bf16_t* Y = WSP(bf16_t, WS_Y);
    constexpr int NBLK = (TC + T) / SB;
    for (int task = F.bx; task < NB * NH * 2 * 2; task += F.G) {
        const int hf = (task >> 3) & 1, id_ = ((task >> 4) << 3) | (task & 7), d = id_ & 1, h = (id_ >> 1) & 15, b = id_ >> 5;
        __syncthreads();
        if (F.wave >= 4) {
            const int lt = F.tid - 256, lstep = lt >> 3, lpc = lt & 7;
            const bf16_t* Up = WSP(bf16_t, WS_SC) + (size_t)d * (SC_STRIDE / 2); const bf16_t* SBb = WSP(bf16_t, WS_SB);
            const bf16_t* arr[4] = { SBb + (size_t)SB_NKK * (SB_STRIDE / 2), SBb + (size_t)(SB_BB + d) * (SB_STRIDE / 2), SBb + (size_t)(SB_KD + d) * (SB_STRIDE / 2), SBb + (size_t)SB_R * (SB_STRIDE / 2) };
            const bf16_t* Vp = SBb + (size_t)SB_V * (SB_STRIDE / 2);
            struct Stage { u32x4 w; u32x4 o[4]; u32x4 v; };
            Stage sy;
#define P4_ISSUE(st, blk) do { const size_t ro = (size_t)scan_row((blk) * SB + lstep, b, d) * DR + h * 64; \
                st.w = *(const u32x4*)(Up + ro + lpc * 8); \
                _Pragma("unroll") for (int a = 0; a < 4; ++a) st.o[a] = *(const u32x4*)(arr[a] + ro + lpc * 8); \
                if (lpc < 4) st.v = *(const u32x4*)(Vp + ro + hf * 32 + lpc * 8); } while (0)
#define P4_CVTLO(u) ((f32x4){__builtin_bit_cast(float, (u).x << 16), __builtin_bit_cast(float, (u).x & 0xffff0000u), __builtin_bit_cast(float, (u).y << 16), __builtin_bit_cast(float, (u).y & 0xffff0000u)})
#define P4_CVTHI(u) ((f32x4){__builtin_bit_cast(float, (u).z << 16), __builtin_bit_cast(float, (u).z & 0xffff0000u), __builtin_bit_cast(float, (u).w << 16), __builtin_bit_cast(float, (u).w & 0xffff0000u)})
#define P4_COMMIT(st, slot) do { LAS unsigned char* sb_ = F.lds + (slot) * SLOT_BYTES + lstep * 256 + lpc * 32; \
                { const f32x4 u0_ = P4_CVTLO(st.w), u1_ = P4_CVTHI(st.w); *(LAS f32x4*)(sb_) = (f32x4){__expf(-u0_.x), __expf(-u0_.y), __expf(-u0_.z), __expf(-u0_.w)}; *(LAS f32x4*)(sb_ + 16) = (f32x4){__expf(-u1_.x), __expf(-u1_.y), __expf(-u1_.z), __expf(-u1_.w)}; } \
                _Pragma("unroll") for (int a = 0; a < 4; ++a) { *(LAS f32x4*)(sb_ + (a + 1) * (SB * 256)) = P4_CVTLO(st.o[a]); *(LAS f32x4*)(sb_ + (a + 1) * (SB * 256) + 16) = P4_CVTHI(st.o[a]); } \
                if (lpc < 4) { LAS unsigned char* vb_ = F.lds + (slot) * SLOT_BYTES + 5 * (SB * 256) + lstep * 128 + lpc * 32; *(LAS f32x4*)(vb_) = P4_CVTLO(st.v); *(LAS f32x4*)(vb_ + 16) = P4_CVTHI(st.v); } } while (0)
            P4_ISSUE(sy, 0); P4_COMMIT(sy, 0);
            P4_ISSUE(sy, 1);
            LAS unsigned char* cvtile = F.lds + YB_OFF + 2 * YB_BYTES;
            const int cvkq = F.wave - 4; int cvcur = 0, cvpb = 0; bool cvpend = false; unsigned char* cvpdst = nullptr;
            const int cvstride = F.G * 4; int cvit = (task == F.bx) ? F.bx * 4 + (F.wave - 4) : CV_ITEMS;
            f32x4 cvv[16]; CvItem cvt = cv_decode(F, cvit < CV_ITEMS ? cvit : 0); bool cvhave = cvit < CV_ITEMS;
            if (cvhave) CV_LOAD(cvv, cvt, F.lane);
            const int cvph = (F.bx >> 3) % 17;
            asm volatile("s_waitcnt lgkmcnt(0)" ::: "memory"); __builtin_amdgcn_s_barrier(); asm volatile("" ::: "memory");
            for (int blk = 0; blk < NBLK; ++blk) {
                if (blk + 1 < NBLK) P4_COMMIT(sy, (blk + 1) & 1);
                if (blk + 2 < NBLK) P4_ISSUE(sy, blk + 2);
                if (blk > 0 && (blk - 1) * SB >= TC) {
                    const LAS float* yb = (const LAS float*)(F.lds + YB_OFF + ((blk - 1) & 1) * YB_BYTES);
                    const int row = scan_row((blk - 1) * SB + lstep, b, d);
                    st_bf4(Y + (size_t)d * M_LAT * DR + (size_t)row * DR + h * 64 + hf * 32 + lpc * 4, *(const LAS f32x4*)(yb + lstep * 32 + lpc * 4));
                }
                const int cvq = blk + cvph; const bool cvdo = ((cvq + 1) * 12) / 17 != (cvq * 12) / 17;
                if (cvpend) { cv_flush(cvtile + cvpb * 16384, cvpdst, cvkq, F.lane); cvpend = false; }
                if (cvhave && cvdo) { cv_put(cvv, cvtile + cvcur * 16384, cvkq, F.lane); cvpend = true; cvpb = cvcur; cvpdst = cvt.dst; cvcur ^= 1;
                    cvit += cvstride; cvhave = cvit < CV_ITEMS; if (cvhave) { cvt = cv_decode(F, cvit); CV_LOAD(cvv, cvt, F.lane); } }
                asm volatile("s_waitcnt lgkmcnt(0)" ::: "memory"); __builtin_amdgcn_s_barrier(); asm volatile("" ::: "memory");
            }
            if (cvpend) { cv_flush(cvtile + cvpb * 16384, cvpdst, cvkq, F.lane); cvpend = false; }
            {   const LAS float* yb = (const LAS float*)(F.lds + YB_OFF + ((NBLK - 1) & 1) * YB_BYTES);
                const int row = scan_row((NBLK - 1) * SB + lstep, b, d);
                st_bf4(Y + (size_t)d * M_LAT * DR + (size_t)row * DR + h * 64 + hf * 32 + lpc * 4, *(const LAS f32x4*)(yb + lstep * 32 + lpc * 4)); }
#undef P4_ISSUE
#undef P4_COMMIT
#undef P4_CVTLO
#undef P4_CVTHI
        } else {
            const int g = F.lane >> 4, kap = F.lane & 15, rown = 8 * F.wave + 2 * g + (kap & 1), roth = rown ^ 1;
            f32x2 s0 = {0.f, 0.f}, s1 = {0.f, 0.f}, s2 = {0.f, 0.f}, s3 = {0.f, 0.f};
            asm volatile("s_waitcnt lgkmcnt(0)" ::: "memory"); __builtin_amdgcn_s_barrier(); asm volatile("" ::: "memory");
            for (int blk = 0; blk < NBLK; ++blk) {
                const LAS unsigned char* sb = F.lds + (blk & 1) * SLOT_BYTES;
                LAS float* yb = (LAS float*)(F.lds + YB_OFF + (blk & 1) * YB_BYTES);
                const unsigned aK = (unsigned)(size_t)(sb) + kap * 16, aVo = (unsigned)(size_t)(sb) + 5 * (SB * 256) + rown * 4, aVt = (unsigned)(size_t)(sb) + 5 * (SB * 256) + roth * 4;
                f32x4 cw, ca, cb, ck, cr; float cvo, cvt;
#define P4_RDSET(P, base_, boff_, vo_, vt_, voff_) do { P##w = lds_rd128<(boff_)>(base_); P##a = lds_rd128<(boff_) + SB * 256>(base_); P##b = lds_rd128<(boff_) + 2 * SB * 256>(base_); \
                    P##k = lds_rd128<(boff_) + 3 * SB * 256>(base_); P##r = lds_rd128<(boff_) + 4 * SB * 256>(base_); P##vo = lds_rd32<(voff_)>(vo_); P##vt = lds_rd32<(voff_)>(vt_); } while (0)
#define P4_TIE(P) "+v"(P##w), "+v"(P##a), "+v"(P##b), "+v"(P##k), "+v"(P##r), "+v"(P##vo), "+v"(P##vt)
                P4_RDSET(c, aK, 0, aVo, aVt, 0);
                asm volatile("s_waitcnt lgkmcnt(0)" : P4_TIE(c));
                {
                    float ykeep = 0.f; const unsigned aK0 = aK, aVo0 = aVo, aVt0 = aVt;
#define P4_DPP " row_mask:0xf bank_mask:0xf bound_ctrl:1\n\t"
#define P4_Y(ctl, prev) prev("v_add_f32_dpp %[yv], %[yv], %[yv] " ctl P4_DPP)
#define P4_YES(x) x
#define P4_NOP(x) "s_nop 0\n\t"
#define P4_BODY(SEL) \
                            "v_pk_mul_f32 v[250:251], %[s0], %[al] op_sel_hi:[1,0]\n\t" \
                            "v_pk_fma_f32 v[250:251], %[s1], %[al], v[250:251] op_sel:[0,1,0] op_sel_hi:[1,1,1]\n\t" \
                            "v_pk_fma_f32 v[250:251], %[s2], %[ah], v[250:251] op_sel_hi:[1,0,1]\n\t" \
                            "v_pk_fma_f32 v[250:251], %[s3], %[ah], v[250:251] op_sel:[0,1,0] op_sel_hi:[1,1,1]\n\t" \
                            "v_pk_mul_f32 %[t0], %[cv], %[kl] op_sel_hi:[1,0]\n\t" \
                            "v_pk_mul_f32 %[t1], %[cv], %[kl] op_sel:[0,1] op_sel_hi:[1,1]\n\t" \
                            "v_add_f32_dpp v252, v251, v250 quad_perm:[1,0,3,2]" P4_DPP \
                            SEL("v_add_f32_dpp %[yv], %[qy], %[qx] quad_perm:[1,0,3,2]" P4_DPP) \
                            "v_pk_mul_f32 %[t2], %[cv], %[kh] op_sel_hi:[1,0]\n\t" \
                            "v_add_f32_dpp v252, v252, v252 quad_perm:[2,3,0,1]" P4_DPP \
                            P4_Y("quad_perm:[2,3,0,1]", SEL) \
                            "v_pk_mul_f32 %[t3], %[cv], %[kh] op_sel:[0,1] op_sel_hi:[1,1]\n\t" \
                            "v_add_f32_dpp v252, v252, v252 row_ror:4" P4_DPP \
                            P4_Y("row_ror:4", SEL) \
                            "v_pk_fma_f32 %[t0], %[s0], %[wl], %[t0] op_sel_hi:[1,0,1]\n\t" \
                            "v_add_f32_dpp v252, v252, v252 row_ror:8" P4_DPP \
                            P4_Y("row_ror:8", SEL) \
                            "v_pk_fma_f32 %[t1], %[s1], %[wl], %[t1] op_sel:[0,1,0] op_sel_hi:[1,1,1]\n\t" \
                            "v_mov_b32_dpp v253, v252 quad_perm:[1,0,3,2]" P4_DPP \
                            "v_pk_fma_f32 %[t2], %[s2], %[wh], %[t2] op_sel_hi:[1,0,1]\n\t" \
                            "v_pk_fma_f32 %[t3], %[s3], %[wh], %[t3] op_sel:[0,1,0] op_sel_hi:[1,1,1]\n\t" \
                            "v_pk_fma_f32 %[s0], v[252:253], %[bl], %[t0] op_sel_hi:[1,0,1]\n\t" \
                            "v_pk_fma_f32 %[s1], v[252:253], %[bl], %[t1] op_sel:[0,1,0] op_sel_hi:[1,1,1]\n\t" \
                            "v_pk_fma_f32 %[s2], v[252:253], %[bh], %[t2] op_sel_hi:[1,0,1]\n\t" \
                            "v_pk_fma_f32 %[s3], v[252:253], %[bh], %[t3] op_sel:[0,1,0] op_sel_hi:[1,1,1]\n\t" \
                            "v_pk_mul_f32 %[qq], %[s0], %[rl] op_sel_hi:[1,0]\n\t" \
                            "v_pk_fma_f32 %[qq], %[s1], %[rl], %[qq] op_sel:[0,1,0] op_sel_hi:[1,1,1]\n\t" \
                            "v_pk_fma_f32 %[qq], %[s2], %[rh], %[qq] op_sel_hi:[1,0,1]\n\t" \
                            "v_pk_fma_f32 %[qq], %[s3], %[rh], %[qq] op_sel:[0,1,0] op_sel_hi:[1,1,1]\n\t"
#define P4_STEP(II, HASPREV) do { f32x4 nw, na, nb, nk, nr; float nvo, nvt; \
                        asm volatile("" : "+v"(s0)); \
                        P4_RDSET(n, aK0, ((II) + 1) * 256, aVo0, aVt0, ((II) + 1) * 128); \
                        f32x2 cvp; cvp.x = cvo; cvp.y = cvt; f32x2 t0, t1, t2, t3, qn; float yv = 0.f; \
                        if (HASPREV) { \
                            asm(P4_BODY(P4_YES) \
                                : [s0] "+v"(s0), [s1] "+v"(s1), [s2] "+v"(s2), [s3] "+v"(s3), [t0] "=&v"(t0), [t1] "=&v"(t1), [t2] "=&v"(t2), [t3] "=&v"(t3), [yv] "=&v"(yv), [qq] "=&v"(qn) \
                                : [al] "v"(LO2(ca)), [ah] "v"(HI2(ca)), [bl] "v"(LO2(cb)), [bh] "v"(HI2(cb)), [wl] "v"(LO2(cw)), [wh] "v"(HI2(cw)), [kl] "v"(LO2(ck)), [kh] "v"(HI2(ck)), [rl] "v"(LO2(cr)), [rh] "v"(HI2(cr)), [cv] "v"(cvp), [qx] "v"(qq.x), [qy] "v"(qq.y) : "v250", "v251", "v252", "v253"); \
                            ykeep = ((kap >> 1) == (((II) - 1) & 7)) ? yv : ykeep; \
                            if ((((II) - 1) & 7) == 7) { yb[((II) - 8 + (kap >> 1)) * 32 + rown] = ykeep; ykeep = 0.f; } \
                        } else { \
                            asm(P4_BODY(P4_NOP) \
                                : [s0] "+v"(s0), [s1] "+v"(s1), [s2] "+v"(s2), [s3] "+v"(s3), [t0] "=&v"(t0), [t1] "=&v"(t1), [t2] "=&v"(t2), [t3] "=&v"(t3), [qq] "=&v"(qn) \
                                : [al] "v"(LO2(ca)), [ah] "v"(HI2(ca)), [bl] "v"(LO2(cb)), [bh] "v"(HI2(cb)), [wl] "v"(LO2(cw)), [wh] "v"(HI2(cw)), [kl] "v"(LO2(ck)), [kh] "v"(HI2(ck)), [rl] "v"(LO2(cr)), [rh] "v"(HI2(cr)), [cv] "v"(cvp) : "v250", "v251", "v252", "v253"); \
                        } \
                        qq = qn; \
                        asm volatile("s_waitcnt lgkmcnt(0)" : P4_TIE(n), "+v"(s0)); \
                        cw = nw; ca = na; cb = nb; ck = nk; cr = nr; cvo = nvo; cvt = nvt; } while (0)
                    f32x2 qq;
                    P4_STEP(0, false); P4_STEP(1, true); P4_STEP(2, true); P4_STEP(3, true); P4_STEP(4, true); P4_STEP(5, true); P4_STEP(6, true); P4_STEP(7, true);
                    P4_STEP(8, true); P4_STEP(9, true); P4_STEP(10, true); P4_STEP(11, true); P4_STEP(12, true); P4_STEP(13, true); P4_STEP(14, true); P4_STEP(15, true);
                    P4_STEP(16, true); P4_STEP(17, true); P4_STEP(18, true); P4_STEP(19, true); P4_STEP(20, true); P4_STEP(21, true); P4_STEP(22, true); P4_STEP(23, true);
                    P4_STEP(24, true); P4_STEP(25, true); P4_STEP(26, true); P4_STEP(27, true); P4_STEP(28, true); P4_STEP(29, true); P4_STEP(30, true); P4_STEP(31, true);
#undef P4_STEP
#undef P4_BODY
#undef P4_Y
#undef P4_YES
#undef P4_NOP
#undef P4_DPP
                    { const float y7 = pair16_sum(qq); ykeep = ((kap >> 1) == 7) ? y7 : ykeep; }
                    yb[(24 + (kap >> 1)) * 32 + rown] = ykeep;
                }
#undef P4_RDSET
#undef P4_TIE
                asm volatile("s_waitcnt lgkmcnt(0)" ::: "memory"); __builtin_amdgcn_s_barrier(); asm volatile("" ::: "memory");
            }
        }
        __syncthreads();
    }
    if (F.wave == 4) { f32x4 cvv[16]; LAS unsigned char* lt = F.lds + YB_OFF + 2 * YB_BYTES;
        for (int sit = F.bx + (F.bx < NB * NH * 2 * 2 ? 96 : 0) * F.G; sit < CV_ITEMS / 4; sit += F.G) {
            for (int kq = 0; kq < 4; ++kq) { const CvItem tq = cv_decode(F, 4 * sit + kq); CV_LOAD(cvv, tq, F.lane); cv_put(cvv, lt, kq, F.lane); }
            LDS_WAIT(); asm volatile("" ::: "memory");
            const CvItem t0 = cv_decode(F, 4 * sit);
            for (int kq = 0; kq < 4; ++kq) cv_flush(lt, t0.dst, kq, F.lane);
            LDS_WAIT(); asm volatile("" ::: "memory"); } }
    __syncthreads();
}

__device__ __forceinline__ f32x4 row16_sum4(f32x4 v) { return (f32x4){row16_sum(v.x), row16_sum(v.y), row16_sum(v.z), row16_sum(v.w)}; }
__device__ __forceinline__ void p5_readout(Frame& F) {
    const bf16_t* SBb = WSP(bf16_t, WS_SB); const bf16_t* Y = WSP(bf16_t, WS_Y); const bf16_t* G = WSP(bf16_t, WS_G);
    const bf16_t* P = WSP(bf16_t, WS_P); bf16_t* MI = WSP(bf16_t, WS_MIXIN);
    const int t4 = F.lane >> 4, q = F.lane & 15;
    f32x4 rk[2], lw[2], lb[2];
#pragma unroll
    for (int hh = 0; hh < 2; ++hh) { const int c = (F.wave + 8 * hh) * 64 + 4 * q; rk[hh] = *(const f32x4*)(IN_RK + c); lw[hh] = *(const f32x4*)(IN_LNXW + c); lb[hh] = *(const f32x4*)(IN_LNXB + c); }
    const int cc = 128 * F.wave + 8 * q;
    f32x4 cw[3][2];
#pragma unroll
    for (int k = 0; k < 3; ++k) { cw[k][0] = *(const f32x4*)(IN_CONVW + k * DC + cc); cw[k][1] = *(const f32x4*)(IN_CONVW + k * DC + cc + 4); }
    for (int tg = F.bx; tg < M_LAT / 4; tg += F.G) {
        const int tok = 4 * tg + t4;
#pragma unroll
        for (int hh = 0; hh < 2; ++hh) {
            const int c = (F.wave + 8 * hh) * 64 + 4 * q; const size_t o = (size_t)tok * DR + c;
            const f32x4 v = ld_bf4(SBb + (size_t)SB_V * (SB_STRIDE / 2) + o), g = ld_bf4(G + o);
            const f32x2 bon = *(const f32x2*)(WSP(float, WS_XG) + ((size_t)tok * NH + (F.wave + 8 * hh)) * 2);
            f32x4 osum = (f32x4){0.f, 0.f, 0.f, 0.f};
#pragma unroll
            for (int d = 0; d < 2; ++d) {
                const f32x4 y = ld_bf4(Y + (size_t)d * M_LAT * DR + o);
                const float mu = row16_sum((y.x + y.y) + (y.z + y.w)) * (1.0f / 64.0f); const f32x4 dy = y - mu;
                const float var = row16_sum((dy.x * dy.x + dy.y * dy.y) + (dy.z * dy.z + dy.w * dy.w)) * (1.0f / 64.0f);
                const float bonus = d ? bon.y : bon.x;
                osum += dy * __builtin_amdgcn_rsqf(var + LNX_EPS) * lw[hh] + lb[hh] + bonus * v;
            }
            st_bf4(MI + (size_t)tok * D + DC + c, osum * g);
        }
        {
            const int col = tok & 63; const bf16_t* pr = P + (size_t)tok * P_PAD + cc;
            f32x4 gb0, gb1, gc0, gc1, u0, u1, pg0, pg1, pu0, pu1, ng0, ng1, nu0, nu1; const f32x4 z = (f32x4){0.f, 0.f, 0.f, 0.f};
            ld_bf8(pr, gb0, gb1); ld_bf8(pr + DC, gc0, gc1); ld_bf8(pr + 2 * DC, u0, u1);
            if (col > 0) { ld_bf8(pr - P_PAD + DC, pg0, pg1); ld_bf8(pr - P_PAD + 2 * DC, pu0, pu1); } else { pg0 = z; pg1 = z; pu0 = z; pu1 = z; }
            if (col < 63) { ld_bf8(pr + P_PAD + DC, ng0, ng1); ld_bf8(pr + P_PAD + 2 * DC, nu0, nu1); } else { ng0 = z; ng1 = z; nu0 = z; nu1 = z; }
            const f32x4 o0 = gb0 * ((pg0 * pu0) * cw[0][0] + (gc0 * u0) * cw[1][0] + (ng0 * nu0) * cw[2][0]);
            const f32x4 o1 = gb1 * ((pg1 * pu1) * cw[0][1] + (gc1 * u1) * cw[1][1] + (ng1 * nu1) * cw[2][1]);
            u32x4 w; w.x = pg8::cvt_pk_bf16(o0.x, o0.y); w.y = pg8::cvt_pk_bf16(o0.z, o0.w); w.z = pg8::cvt_pk_bf16(o1.x, o1.y); w.w = pg8::cvt_pk_bf16(o1.z, o1.w);
            *(u32x4*)(MI + (size_t)tok * D + cc) = w;
        }
    }
}

template <bool FAST>
__device__ __forceinline__ void p7_route_t(Frame& F, const bool do_route) {
    const float* mod = WSP(float, WS_MOD); const bf16_t* MIX = WSP(bf16_t, WS_MIX); bf16_t* X1 = WSP(bf16_t, WS_X1); unsigned char* H2 = WSP(unsigned char, WS_H2);
    int* tok_e = WSP(int, WS_ROUTE); int* tok_rank = tok_e + M_LAT * TOPK; float* tok_gate = (float*)(tok_rank + M_LAT * TOPK); int* elist = (int*)(tok_gate + M_LAT * TOPK);
    unsigned* cnt = WSP(unsigned, WS_CTL) + CW_CNT;
    const int gw = F.bx * NWAVES + F.wave, NGW = F.G * NWAVES, rep = F.bx % RR;
    LAS unsigned* lcnt = (LAS unsigned*)F.lds;
    LAS float* hbuf = (LAS float*)(F.lds + 1024);
    LAS float* part = (LAS float*)(F.lds + 1024 + 65536);
    LAS float* lgb = (LAS float*)(F.lds + 1024 + 65536 + 32768);
    LAS float* pvec = (LAS float*)(F.lds + 100352);
    const int NIT = (M_LAT + NGW - 1) / NGW;
    __syncthreads();
    if (F.tid < 64) lcnt[F.tid] = 0u;
    if (FAST) { const float* mr = mod + ((F.bx * NIT * 8) / T) * NMOD;
        for (int c = 4 * F.tid; c < D; c += 4 * NTHR) {
            *(LAS f32x4*)(pvec + c) = *(const f32x4*)(mr + 2 * D + c) * *(const f32x4*)(IN_NORMG + D + c);
            *(LAS f32x4*)(pvec + D + c) = *(const f32x4*)(IN_NORMG + 2 * D + c) * (*(const f32x4*)(mr + 4 * D + c) + 1.0f);
            *(LAS f32x4*)(pvec + 2 * D + c) = *(const f32x4*)(mr + 3 * D + c); } }
    __syncthreads();
    const int re = F.tid & 31;
    for (int it = 0; it < NIT; ++it) {
        const int row_ = FAST ? (F.bx * NIT + it) * 8 + F.wave : gw + it * NGW;
        const bool valid = row_ < M_LAT; const int row = valid ? row_ : M_LAT - 1;
        const float* mr = mod + (row / T) * NMOD;
        f32x4 v[8], xv[8]; float ss = 0.f;
#pragma unroll
        for (int j = 0; j < 8; ++j) { v[j] = ld_bf4(MIX + (size_t)row * D + 4 * F.lane + 256 * j); xv[j] = *(const f32x4*)(IN_X + (size_t)row * D + 4 * F.lane + 256 * j); }
#pragma unroll
        for (int j = 0; j < 8; ++j) ss += (v[j].x * v[j].x + v[j].y * v[j].y) + (v[j].z * v[j].z + v[j].w * v[j].w);
        float rstd = __builtin_amdgcn_rsqf(wave_sum(ss) * (1.0f / D) + RMS_EPS);
        ss = 0.f;
#pragma unroll
        for (int j = 0; j < 8; ++j) { const int c = 4 * F.lane + 256 * j;
            const f32x4 gg = FAST ? *(const LAS f32x4*)(pvec + c) : *(const f32x4*)(IN_NORMG + D + c) * *(const f32x4*)(mr + 2 * D + c);
            v[j] = xv[j] + gg * (v[j] * rstd);
            if (valid) st_bf4(X1 + (size_t)row * D + c, v[j]);
            ss += (v[j].x * v[j].x + v[j].y * v[j].y) + (v[j].z * v[j].z + v[j].w * v[j].w); }
        rstd = __builtin_amdgcn_rsqf(wave_sum(ss) * (1.0f / D) + RMS_EPS);
#pragma unroll
        for (int j = 0; j < 8; ++j) { const int c = 4 * F.lane + 256 * j;
            const f32x4 gs = FAST ? *(const LAS f32x4*)(pvec + D + c) : *(const f32x4*)(IN_NORMG + 2 * D + c) * (*(const f32x4*)(mr + 4 * D + c) + 1.0f);
            const f32x4 sh = FAST ? *(const LAS f32x4*)(pvec + 2 * D + c) : *(const f32x4*)(mr + 3 * D + c);
            const f32x4 hv = (v[j] * rstd) * gs + sh;
            if (valid) *(unsigned*)(H2 + (size_t)row * D + c) = pg8::pk4_fp8(hv.x, hv.y, hv.z, hv.w);
            *(LAS f32x4*)(hbuf + F.wave * D + c) = hv; }
        __syncthreads();
        {
            f32x4 acc[8];
#pragma unroll
            for (int r = 0; r < 8; ++r) acc[r] = (f32x4){0.f, 0.f, 0.f, 0.f};
            const int cg = F.lane >> 3, eq = F.lane & 7;
            const float* wp = IN_WROUTER + (size_t)(256 * F.wave + cg) * NE + 4 * eq;
            const LAS float* hp = hbuf + 256 * F.wave + cg;
#pragma unroll 8
            for (int it = 0; it < 32; ++it) { const f32x4 w4 = *(const f32x4*)(wp + (size_t)(8 * it) * NE);
#pragma unroll
                for (int r = 0; r < 8; ++r) acc[r] += hp[r * D + 8 * it] * w4; }
#pragma unroll
            for (int r = 0; r < 8; ++r) { acc[r].x = dpp_add<0x128>(acc[r].x); acc[r].y = dpp_add<0x128>(acc[r].y); acc[r].z = dpp_add<0x128>(acc[r].z); acc[r].w = dpp_add<0x128>(acc[r].w); }
            if (!(cg & 1)) {
#pragma unroll
                for (int r = 0; r < 8; ++r) *(LAS f32x4*)(part + ((F.wave * 4 + (cg >> 1)) * 8 + r) * 32 + 4 * eq) = acc[r]; }
        }
        __syncthreads();
        if (F.tid < 256) { const int r = F.tid >> 5; float s = IN_BROUTER[re];
#pragma unroll 16
            for (int j = 0; j < 32; ++j) s += part[(j * 8 + r) * 32 + re];
            lgb[r * 32 + re] = s; }
        __syncthreads();
        float lg[NE];
#pragma unroll
        for (int e4 = 0; e4 < NE / 4; ++e4) { const f32x4 t = *(const LAS f32x4*)(lgb + F.wave * 32 + 4 * e4); lg[4 * e4] = t.x; lg[4 * e4 + 1] = t.y; lg[4 * e4 + 2] = t.z; lg[4 * e4 + 3] = t.w; }
        unsigned taken = 0u; int es[TOPK]; float vs[TOPK];
#pragma unroll
        for (int k = 0; k < TOPK; ++k) { float best = -3.0e38f; int bi = 0;
#pragma unroll
            for (int e = 0; e < NE; ++e) { const bool ok = !((taken >> e) & 1u) && lg[e] > best; best = ok ? lg[e] : best; bi = ok ? e : bi; }
            taken |= 1u << bi; es[k] = bi; vs[k] = best; }
        float ps[TOPK], psum = 0.f;
#pragma unroll
        for (int k = 0; k < TOPK; ++k) { ps[k] = __expf(vs[k] - vs[0]); psum += ps[k]; }
        if (do_route && valid && F.lane < TOPK) {
            const int k = F.lane; const int e = k == 0 ? es[0] : k == 1 ? es[1] : k == 2 ? es[2] : es[3]; const float p = k == 0 ? ps[0] : k == 1 ? ps[1] : k == 2 ? ps[2] : ps[3];
            const int lr = (int)__hip_atomic_fetch_add(lcnt + e, 1u, __ATOMIC_RELAXED, __HIP_MEMORY_SCOPE_WORKGROUP);
            tok_e[row * TOPK + k] = e; tok_rank[row * TOPK + k] = lr; tok_gate[row * TOPK + k] = p / psum;
        }
    }
    if (!do_route) return;
    __syncthreads();
    if (F.tid < NE) { const unsigned c = lcnt[F.tid]; lcnt[32 + F.tid] = c ? atomicAdd(cnt + (rep * NE + F.tid) * 16, c) : 0u; }
    __syncthreads();
    for (int it = 0; it < NIT; ++it) { const int row = FAST ? (F.bx * NIT + it) * 8 + F.wave : gw + it * NGW;
        if (row < M_LAT && F.lane < TOPK) { const int e = tok_e[row * TOPK + F.lane]; const int idx = (int)lcnt[32 + e] + tok_rank[row * TOPK + F.lane];
            tok_rank[row * TOPK + F.lane] = idx; elist[((size_t)e * RR + rep) * RCAP + idx] = row; } }
}
__device__ __forceinline__ void p7_route(Frame& F, const bool do_route) {
    const int nit = (M_LAT + F.G * NWAVES - 1) / (F.G * NWAVES);
    (void)nit; p7_route_t<true>(F, do_route);
}

__device__ __forceinline__ void p11_final(Frame& F) {
    build_tab(F);
    const LAS int* tab = (const LAS int*)(F.lds + TAB_OFF); const LAS int* rp = (const LAS int*)(F.lds + RP_OFF);
    const float* mod = WSP(float, WS_MOD); const bf16_t* X1 = WSP(bf16_t, WS_X1); const unsigned char* YM = WSP(unsigned char, WS_YM);
    const int* tok_e = WSP(int, WS_ROUTE); const int* tok_rank = tok_e + M_LAT * TOPK; const float* tok_gate = (const float*)(tok_rank + M_LAT * TOPK);
    const int gw = F.bx * NWAVES + F.wave, NGW = F.G * NWAVES;
    for (int row = gw; row < M_LAT; row += NGW) {
        const float* mr = mod + (row / T) * NMOD;
        f32x4 v[8];
#pragma unroll
        for (int j = 0; j < 8; ++j) v[j] = (f32x4){0.f, 0.f, 0.f, 0.f};
#pragma unroll
        for (int k = 0; k < TOPK; ++k) {
            const int e = tok_e[row * TOPK + k], rank = tok_rank[row * TOPK + k]; const float gt = tok_gate[row * TOPK + k];
            const unsigned char* yr = YM + (size_t)(tab[e] + rp[e * RR + (row / (8 * ((M_LAT + NGW - 1) / NGW))) % RR] + rank) * D;
#pragma unroll
            for (int j = 0; j < 8; ++j) { const int w = *(const int*)(yr + 4 * F.lane + 256 * j);
                const f32x2 lo = __builtin_amdgcn_cvt_pk_f32_fp8(w, false), hi = __builtin_amdgcn_cvt_pk_f32_fp8(w, true);
                v[j].x += gt * lo.x; v[j].y += gt * lo.y; v[j].z += gt * hi.x; v[j].w += gt * hi.y; }
        }
        float ss = 0.f;
#pragma unroll
        for (int j = 0; j < 8; ++j) ss += (v[j].x * v[j].x + v[j].y * v[j].y) + (v[j].z * v[j].z + v[j].w * v[j].w);
        const float rstd = __builtin_amdgcn_rsqf(wave_sum(ss) * (1.0f / D) + RMS_EPS);
#pragma unroll
        for (int j = 0; j < 8; ++j) { const int c = 4 * F.lane + 256 * j;
            const f32x4 xv = ld_bf4(X1 + (size_t)row * D + c), g = *(const f32x4*)(IN_NORMG + 3 * D + c), gt = *(const f32x4*)(mr + 5 * D + c);
            *(f32x4*)(F.out + (size_t)row * D + c) = xv + gt * (v[j] * rstd * g); }
    }
}

#ifndef MK_N_LAUNCHES
#define MK_N_LAUNCHES 1
#endif
constexpr int N_PHASES = 12;
struct Args { const float* in[27]; float* out; unsigned char* ws; int ph_lo, ph_hi; };
__global__ void __launch_bounds__(NTHR, 2) fwd_kernel(Args args) {
    extern __shared__ __attribute__((aligned(16))) unsigned char lds_raw[];
    Frame F;
    F.lds = (LAS unsigned char*)lds_raw;
    F.tid = threadIdx.x; F.lane = F.tid & 63; F.wave = __builtin_amdgcn_readfirstlane(F.tid >> 6);
    F.G = gridDim.x; F.bx = blockIdx.x;
#pragma unroll
    for (int i = 0; i < 27; ++i) F.in[i] = args.in[i];
    F.out = args.out; F.ws = args.ws;
    volatile LAS unsigned* MISC = (volatile LAS unsigned*)(F.lds + MISC_OFF);
    if (F.tid < 64) MISC[F.tid] = 0u;
    __syncthreads();
    XcdBarrier bar; bar.bar = WSP(unsigned, WS_CTL) + CW_BAR; bar.x = 0; bar.st = nullptr;
    if (MK_N_LAUNCHES == 1) bar = xcd_barrier_post(WSP(unsigned, WS_CTL) + CW_BAR, MISC + 8);
    const int lo = args.ph_lo, hi = args.ph_hi;
#define IN(k) (lo <= (k) && (k) < hi)
#define SEAM(k) do { if (IN(k) && IN((k) + 1)) xcd_barrier(bar); } while (0)

    if (IN(0)) { p0_prologue(F); SEAM(0); }
    if (IN(1)) { p1_norm(F); SEAM(1); }
    if (IN(2)) {
        const int n = build_list(F, 0);
        pg8::Gemm g{WSP(bf16_t, WS_H), WSP(bf16_t, WS_WIN), 2 * D}; pg8::ListOrder S{(const LAS int*)(F.lds + LIST_OFF), n};
        pg8::EpiBf16S E{WSP(bf16_t, WS_P), P_PAD, nullptr, 1 << 20, 0, 1.0f, F.lds + STG_OFF, F.lds + 3 * pg8::HTB};
        pg8::gemm_phase<pg8::EpiBf16S, pg8::ListOrder, true, false>(F.lds, g, S, E);
        SEAM(2);
    }
    if (IN(3)) { p3_inputs(F); SEAM(3); }
    if (IN(4)) { p4_scan(F); SEAM(4); }
    if (IN(5)) { p5_readout(F); SEAM(5); }
    if (IN(6)) {
        const int n = build_list(F, 1);
        pg8::Gemm g{WSP(bf16_t, WS_MIXIN), WSP(bf16_t, WS_WOUT), 2 * D}; pg8::ListOrder S{(const LAS int*)(F.lds + LIST_OFF), n};
        pg8::EpiBf16S E{WSP(bf16_t, WS_MIX), D, nullptr, 1 << 20, 0, 1.0f, F.lds + STG_OFF, F.lds + 3 * pg8::HTB};
        pg8::gemm_phase<pg8::EpiBf16S, pg8::ListOrder, true, false>(F.lds, g, S, E);
        SEAM(6);
    }
    if (IN(7)) { p7_route(F, true); if (IN(7) && IN(9)) xcd_barrier(bar); }
    if (IN(9)) {
        build_tab(F); const int n = build_list(F, 2);
        pg8::Gemm g{WSP(unsigned char, WS_H2), WSP(unsigned char, WS_WGU), D};
        const pg8::GatherInfo GI{WSP(int, WS_ROUTE) + 3 * M_LAT * TOPK, (const LAS int*)(F.lds + TAB_OFF), (const LAS int*)(F.lds + RP_OFF), 16, RR, RCAP}; pg8::ListOrder S{(const LAS int*)(F.lds + LIST_OFF), n};
        pg8::EpiSwigluS E{WSP(unsigned char, WS_ACT), DE, IN_BGU, 16, 2 * DE, 1.0f / WSCALE, F.lds + STG_OFF};
        pg8::gemm_phase<pg8::EpiSwigluS, pg8::ListOrder, true, true, true>(F.lds, g, S, E, GI);
        SEAM(9);
    }
    if (IN(10)) {
        build_tab(F); const int n = build_list(F, 3);
        pg8::Gemm g{WSP(unsigned char, WS_ACT), WSP(unsigned char, WS_WDN), DE}; pg8::ListOrder S{(const LAS int*)(F.lds + LIST_OFF), n};
        pg8::EpiF8S E{WSP(unsigned char, WS_YM), D, IN_BDN, 8, D, 1.0f / WSCALE, F.lds + STG_OFF};
        pg8::gemm_phase<pg8::EpiF8S, pg8::ListOrder, true, true>(F.lds, g, S, E);
        SEAM(10);
    }
    if (IN(11)) { p11_final(F); }
#undef IN
#undef SEAM
}

extern "C" void kernel_launch(void* const* d_in, const int* in_sizes, int n_in, void* d_out, int out_size, void* d_ws, size_t ws_size, hipStream_t stream) {
    static int grid = 0;
    if (grid == 0) {
        if (n_in != 27 || out_size != M_LAT * D || ws_size < WS_END) { fprintf(stderr, "kernel_launch: bad shapes (n_in %d, out %d, ws %zu < %zu); nothing launched\n", n_in, out_size, ws_size, (size_t)WS_END); grid = -1; return; }
        int dev = 0, cus = 0, per_cu = 0;
        if (hipGetDevice(&dev) != hipSuccess || hipDeviceGetAttribute(&cus, hipDeviceAttributeMultiprocessorCount, dev) != hipSuccess) { grid = -1; return; }
        if (hipFuncSetAttribute((const void*)fwd_kernel, hipFuncAttributeMaxDynamicSharedMemorySize, LDS_BYTES) != hipSuccess) { fprintf(stderr, "kernel_launch: hipFuncSetAttribute failed\n"); grid = -1; return; }
        if (hipOccupancyMaxActiveBlocksPerMultiprocessor(&per_cu, (const void*)fwd_kernel, NTHR, LDS_BYTES) != hipSuccess || per_cu < 1) fprintf(stderr, "kernel_launch: occupancy query reports %d\n", per_cu);
        (void)hipGetLastError();
        grid = cus;
        for (; grid > 1; --grid) { const int nit = (M_LAT + grid * NWAVES - 1) / (grid * NWAVES); if (T % (nit * 8) == 0) break; }
    }
    if (grid < 0) return;
    if (hipMemsetAsync((char*)d_ws + WS_CTL, 0, CTL_ZERO_BYTES, stream) != hipSuccess) return;
    Args a{};
    for (int i = 0; i < 27; ++i) a.in[i] = (const float*)d_in[i];
    a.out = (float*)d_out; a.ws = (unsigned char*)d_ws;
    if (MK_N_LAUNCHES == 1) { a.ph_lo = 0; a.ph_hi = N_PHASES; hipLaunchKernelGGL(fwd_kernel, dim3(grid), dim3(NTHR), LDS_BYTES, stream, a); }
    if (MK_N_LAUNCHES != 1) for (int p = 0; p < N_PHASES; ++p) { a.ph_lo = p; a.ph_hi = p + 1; hipLaunchKernelGGL(fwd_kernel, dim3(grid), dim3(NTHR), LDS_BYTES, stream, a); }
}
```
